# Optimizing an MI355X kernel written in HIP

```python
import jax, jax.numpy as jnp
from jax import lax
import numpy as np

D_MODEL = 1024
BATCH = 4
SEQ = 4096
DEPTH = 1

GRID_W = 64
CTX_LEN = 256
N_HEADS = 8
QK_NOPE_DIM = 64
QK_ROPE_DIM = 32
V_HEAD_DIM = 64
QK_DIM = QK_NOPE_DIM + QK_ROPE_DIM
Q_LORA_RANK = 384
KV_LORA_RANK = 256
ROPE_BASE = 10000.0
Q_BLOCK = 128
LRU_WIDTH = 1280
LRU_BLOCKS = 10
LRU_BLOCK_W = LRU_WIDTH // LRU_BLOCKS
LRU_CONV_W = 4
LRU_C = 8.0
FFN_DIM = 2816
FFN_CONV_W = 3
EPS = 1e-6
OFF_KV = Q_LORA_RANK
OFF_KR = OFF_KV + KV_LORA_RANK
OFF_XB = OFF_KR + QK_ROPE_DIM
OFF_YB = OFF_XB + LRU_WIDTH
OFF_G = OFF_YB + LRU_WIDTH
IN_DIM = OFF_G + 2 * D_MODEL

kernel_name = "hybrid_mla_rglru_convffn_dit_block"


def rms_norm(x, g):
    xf = x.astype(jnp.float32)
    y = xf * lax.rsqrt(jnp.mean(xf * xf, axis=-1, keepdims=True) + EPS)
    return (y * g.astype(jnp.float32)).astype(x.dtype)


def modulate(h, shift, scale):
    return h * (1 + scale) + shift


def dwconv(x, w, b, left, right):
    t = x.shape[1]
    xp = jnp.pad(x, ((0, 0), (left, right), (0, 0)))
    out = b
    for k in range(w.shape[0]):
        out = out + xp[:, k:k + t] * w[k]
    return out


def axial_rope_tables(n):
    rows = n // GRID_W
    row_ids = jnp.repeat(jnp.arange(rows), GRID_W).astype(jnp.float32)
    col_ids = jnp.tile(jnp.arange(GRID_W), rows).astype(jnp.float32)
    axis_dim = QK_ROPE_DIM // 2
    inv = 1.0 / (ROPE_BASE ** (jnp.arange(0, axis_dim, 2, dtype=jnp.float32) / axis_dim))
    ang = jnp.concatenate([row_ids[:, None] * inv, col_ids[:, None] * inv], axis=-1)
    return jnp.cos(ang), jnp.sin(ang)


def apply_rope(x, cos, sin):
    half = QK_ROPE_DIM // 2
    cos = cos.astype(x.dtype)
    sin = sin.astype(x.dtype)
    x1, x2 = x[..., :half], x[..., half:]
    return jnp.concatenate([x1 * cos - x2 * sin, x2 * cos + x1 * sin], axis=-1)


def sdpa(q, k, v):
    s = jnp.einsum('bqhd,bkhd->bhqk', q, k).astype(jnp.float32) * (QK_DIM ** -0.5)
    p = jax.nn.softmax(s, axis=-1).astype(v.dtype)
    return jnp.einsum('bhqk,bkhd->bqhd', p, v)


def attend_blocks(q, k, v):
    b, s, h, dq = q.shape
    nb = s // Q_BLOCK
    qb = q.reshape(b, nb, Q_BLOCK, h, dq).transpose(1, 0, 2, 3, 4)
    ob = lax.map(lambda qq: sdpa(qq, k, v), qb)
    return ob.transpose(1, 0, 2, 3, 4).reshape(b, s, h * V_HEAD_DIM)


def rglru(x, w_a, b_a, w_x, b_x, lam, h0, reverse):
    b, t, w = x.shape
    xb = x.reshape(b, t, LRU_BLOCKS, LRU_BLOCK_W)
    r = jax.nn.sigmoid(jnp.einsum('btnd,nde->btne', xb, w_a).reshape(b, t, w) + b_a)
    i = jax.nn.sigmoid(jnp.einsum('btnd,nde->btne', xb, w_x).reshape(b, t, w) + b_x)
    log_a = -LRU_C * r.astype(jnp.float32) * jax.nn.softplus(-lam.astype(jnp.float32))
    a = jnp.exp(log_a)
    mult = jnp.sqrt(-jnp.expm1(2.0 * log_a))
    u = mult * (i * x).astype(jnp.float32)
    if reverse:
        u = u.at[:, -1].add(a[:, -1] * h0)
    else:
        u = u.at[:, 0].add(a[:, 0] * h0)

    def combine(e1, e2):
        a1, b1 = e1
        a2, b2 = e2
        return a1 * a2, a2 * b1 + b2

    _, h = lax.associative_scan(combine, (a, u), reverse=reverse, axis=1)
    return h


def lru_bidir(xc, lp, h0f, h0b):
    hf = rglru(xc, lp['lru_w_a'][0], lp['lru_b_a'][0], lp['lru_w_x'][0], lp['lru_b_x'][0],
               lp['lru_lambda'][0], h0f, reverse=False)
    hb = rglru(xc, lp['lru_w_a'][1], lp['lru_b_a'][1], lp['lru_w_x'][1], lp['lru_b_x'][1],
               lp['lru_lambda'][1], h0b, reverse=True)
    return hf, hb


def mixer_inputs(h, lp, cos, sin):
    b, t, _ = h.shape
    z = h @ lp['w_in']
    q_lat, kv_lat, k_rope, xb, yb, gl = jnp.split(z, (OFF_KV, OFF_KR, OFF_XB, OFF_YB, OFF_G), axis=-1)
    q = (rms_norm(q_lat, lp['q_norm_g']) @ lp['w_uq']).reshape(b, t, N_HEADS, QK_DIM)
    kv = (rms_norm(kv_lat, lp['kv_norm_g']) @ lp['w_ukv']).reshape(b, t, N_HEADS, QK_NOPE_DIM + V_HEAD_DIM)
    k_nope, v = kv[..., :QK_NOPE_DIM], kv[..., QK_NOPE_DIM:]
    if cos is not None:
        q = jnp.concatenate([q[..., :QK_NOPE_DIM], apply_rope(q[..., QK_NOPE_DIM:], cos[:, None, :], sin[:, None, :])], axis=-1)
        k_rope = apply_rope(k_rope, cos, sin)
    k = jnp.concatenate([k_nope, jnp.broadcast_to(k_rope[:, :, None, :], (b, t, N_HEADS, QK_ROPE_DIM))], axis=-1)
    xc = dwconv(xb, lp['lru_conv_w'], lp['lru_conv_b'], LRU_CONV_W // 2, LRU_CONV_W - 1 - LRU_CONV_W // 2)
    return q, k, v, xc, yb, gl


def merge_out(attn, hf, hb, yb, gl, lp):
    y_a = attn @ lp['w_o_attn']
    y_b = (((hf + hb).astype(yb.dtype)) * jax.nn.gelu(yb)) @ lp['w_o_lru']
    g_a, g_b = jnp.split(jax.nn.sigmoid(gl + lp['b_gate']), 2, axis=-1)
    return (g_a * y_a + g_b * y_b) @ lp['w_out']


def conv_ffn(h, lp):
    u = h @ lp['w_up']
    a, g = jnp.split(u, 2, axis=-1)
    a = dwconv(a, lp['ffn_conv_w'], lp['ffn_conv_b'], FFN_CONV_W // 2, FFN_CONV_W // 2)
    return (jax.nn.silu(a) * g) @ lp['w_down']


def setup_inputs(seed: int = 0) -> dict:
    key = jax.random.key(seed)
    ks = jax.random.split(key, 32)
    f32 = jnp.float32

    def nrm(k, shape, fan_in):
        return jax.random.normal(k, shape, f32) * (fan_in ** -0.5)

    def gain(k, shape):
        return 1.0 + 0.05 * jax.random.normal(k, shape, f32)

    def bias(k, shape):
        return 0.02 * jax.random.normal(k, shape, f32)

    a0 = jax.random.uniform(ks[20], (DEPTH, 2, LRU_WIDTH), f32, 0.9, 0.999)
    return {
        'x': jax.random.normal(ks[0], (BATCH, SEQ, D_MODEL), f32),
        'c': jax.random.normal(ks[1], (BATCH, D_MODEL), f32),
        'ctx': jax.random.normal(ks[2], (BATCH, CTX_LEN, D_MODEL), f32),
        'c_ctx': jax.random.normal(ks[3], (D_MODEL,), f32),
        'w_mod': nrm(ks[4], (DEPTH, D_MODEL, 6 * D_MODEL), D_MODEL),
        'b_mod': bias(ks[5], (DEPTH, 6 * D_MODEL)),
        'norm1_g': gain(ks[6], (DEPTH, D_MODEL)),
        'w_in': nrm(ks[7], (DEPTH, D_MODEL, IN_DIM), D_MODEL),
        'b_gate': bias(ks[8], (DEPTH, 2 * D_MODEL)),
        'q_norm_g': gain(ks[9], (DEPTH, Q_LORA_RANK)),
        'kv_norm_g': gain(ks[10], (DEPTH, KV_LORA_RANK)),
        'w_uq': nrm(ks[11], (DEPTH, Q_LORA_RANK, N_HEADS * QK_DIM), Q_LORA_RANK),
        'w_ukv': nrm(ks[12], (DEPTH, KV_LORA_RANK, N_HEADS * (QK_NOPE_DIM + V_HEAD_DIM)), KV_LORA_RANK),
        'w_o_attn': nrm(ks[13], (DEPTH, N_HEADS * V_HEAD_DIM, D_MODEL), N_HEADS * V_HEAD_DIM),
        'lru_conv_w': nrm(ks[14], (DEPTH, LRU_CONV_W, LRU_WIDTH), LRU_CONV_W),
        'lru_conv_b': bias(ks[15], (DEPTH, LRU_WIDTH)),
        'lru_w_a': nrm(ks[16], (DEPTH, 2, LRU_BLOCKS, LRU_BLOCK_W, LRU_BLOCK_W), LRU_BLOCK_W),
        'lru_b_a': bias(ks[17], (DEPTH, 2, LRU_WIDTH)),
        'lru_w_x': nrm(ks[18], (DEPTH, 2, LRU_BLOCKS, LRU_BLOCK_W, LRU_BLOCK_W), LRU_BLOCK_W),
        'lru_b_x': bias(ks[19], (DEPTH, 2, LRU_WIDTH)),
        'lru_lambda': jnp.log(a0 / (1.0 - a0)),
        'w_o_lru': nrm(ks[21], (DEPTH, LRU_WIDTH, D_MODEL), LRU_WIDTH),
        'w_out': nrm(ks[22], (DEPTH, D_MODEL, D_MODEL), D_MODEL),
        'norm2_g': gain(ks[23], (DEPTH, D_MODEL)),
        'w_up': nrm(ks[24], (DEPTH, D_MODEL, 2 * FFN_DIM), D_MODEL),
        'ffn_conv_w': nrm(ks[25], (DEPTH, FFN_CONV_W, FFN_DIM), FFN_CONV_W),
        'ffn_conv_b': bias(ks[26], (DEPTH, FFN_DIM)),
        'w_down': nrm(ks[27], (DEPTH, FFN_DIM, D_MODEL), FFN_DIM),
        'final_g': gain(ks[28], (D_MODEL,)),
    }


def reference(x, c, ctx, c_ctx, w_mod, b_mod, norm1_g, w_in, b_gate, q_norm_g, kv_norm_g,
              w_uq, w_ukv, w_o_attn, lru_conv_w, lru_conv_b, lru_w_a, lru_b_a, lru_w_x,
              lru_b_x, lru_lambda, w_o_lru, w_out, norm2_g, w_up, ffn_conv_w, ffn_conv_b,
              w_down, final_g):
    b, s, _ = x.shape
    cos, sin = axial_rope_tables(s)
    h_zero = jnp.zeros((b, LRU_WIDTH), jnp.float32)
    for i in range(DEPTH):
        lp = {
            'w_in': w_in[i], 'b_gate': b_gate[i], 'q_norm_g': q_norm_g[i], 'kv_norm_g': kv_norm_g[i],
            'w_uq': w_uq[i], 'w_ukv': w_ukv[i], 'w_o_attn': w_o_attn[i],
            'lru_conv_w': lru_conv_w[i], 'lru_conv_b': lru_conv_b[i],
            'lru_w_a': lru_w_a[i], 'lru_b_a': lru_b_a[i], 'lru_w_x': lru_w_x[i], 'lru_b_x': lru_b_x[i],
            'lru_lambda': lru_lambda[i], 'w_o_lru': w_o_lru[i], 'w_out': w_out[i],
            'w_up': w_up[i], 'ffn_conv_w': ffn_conv_w[i], 'ffn_conv_b': ffn_conv_b[i], 'w_down': w_down[i],
        }
        mod_l = (jax.nn.silu(c) @ w_mod[i] + b_mod[i])[:, None, :]
        mod_c = jax.nn.silu(c_ctx) @ w_mod[i] + b_mod[i]
        sh1_l, sc1_l, g1_l, sh2_l, sc2_l, g2_l = jnp.split(mod_l, 6, axis=-1)
        sh1_c, sc1_c, g1_c, sh2_c, sc2_c, g2_c = jnp.split(mod_c, 6, axis=-1)

        hc = modulate(rms_norm(ctx, norm1_g[i]), sh1_c, sc1_c)
        q_c, k_c, v_c, xc_c, yb_c, gl_c = mixer_inputs(hc, lp, None, None)
        hf_c, hb_c = lru_bidir(xc_c, lp, h_zero, h_zero)
        state_f, state_b = hf_c[:, -1], hb_c[:, 0]

        hl = modulate(rms_norm(x, norm1_g[i]), sh1_l, sc1_l)
        q_l, k_l, v_l, xc_l, yb_l, gl_l = mixer_inputs(hl, lp, cos, sin)
        attn_l = attend_blocks(q_l, jnp.concatenate([k_l, k_c], axis=1), jnp.concatenate([v_l, v_c], axis=1))
        hf_l, hb_l = lru_bidir(xc_l, lp, state_f, state_b)
        x = x + g1_l * merge_out(attn_l, hf_l, hb_l, yb_l, gl_l, lp)
        x = x + g2_l * conv_ffn(modulate(rms_norm(x, norm2_g[i]), sh2_l, sc2_l), lp)

        if i < DEPTH - 1:
            attn_c = sdpa(q_c, k_c, v_c).reshape(b, ctx.shape[1], N_HEADS * V_HEAD_DIM)
            ctx = ctx + g1_c * merge_out(attn_c, hf_c, hb_c, yb_c, gl_c, lp)
            ctx = ctx + g2_c * conv_ffn(modulate(rms_norm(ctx, norm2_g[i]), sh2_c, sc2_c), lp)
    return rms_norm(x, final_g)
```

```cpp
#include <hip/hip_runtime.h>
#include <hip/hip_cooperative_groups.h>
#include <cstdio>
#include <cstdint>
namespace cg = cooperative_groups;

typedef unsigned short bf16_t;
typedef short bf16x8 __attribute__((ext_vector_type(8)));
typedef float f32x4 __attribute__((ext_vector_type(4)));
typedef float f32x16 __attribute__((ext_vector_type(16)));
typedef unsigned u32x4 __attribute__((ext_vector_type(4)));
typedef unsigned u32x2 __attribute__((ext_vector_type(2)));
#define DI __device__ __forceinline__

constexpr int D = 1024, NB = 4, S = 4096, CL = 256;
constexpr int TL = NB * S;
constexpr int TC = NB * CL;
constexpr int TT = TL + TC;
constexpr int NKEY = S + CL;
constexpr int NH = 8, QKD = 96, VD = 64;
constexpr int LW = 1280;
constexpr int FFN = 2816;
constexpr int IN_DIM = 5280;
constexpr float EPS = 1e-6f;
constexpr int ZLD = 3328;
constexpr int ZC_QL = 0, ZC_KVL = 384, ZC_XB = 640, ZC_YB = 1920, ZC_KR = 3200;
constexpr int NT_Z = ZLD / 128;

constexpr size_t OFF_WIN = 0;
constexpr size_t OFF_WG = OFF_WIN + (size_t)ZLD * 1024 * 2;
constexpr size_t OFF_WUQ = OFF_WG + (size_t)2048 * 1024 * 2;
constexpr size_t OFF_WUKV = OFF_WUQ + (size_t)768 * 384 * 2;
constexpr size_t OFF_WOA = OFF_WUKV + (size_t)1024 * 256 * 2;
constexpr size_t OFF_GATES = OFF_WOA + (size_t)1024 * 512 * 2;
constexpr size_t OFF_WOL = OFF_GATES + (size_t)40 * 128 * 128 * 2;
constexpr size_t OFF_WOUT = OFF_WOL + (size_t)1024 * 1280 * 2;
constexpr size_t OFF_WUP = OFF_WOUT + (size_t)1024 * 1024 * 2;
constexpr size_t OFF_WD = OFF_WUP + (size_t)5632 * 1024 * 2;
constexpr size_t OFF_SP = OFF_WD + (size_t)1024 * 2816 * 2;
constexpr size_t OFF_ROPE = OFF_SP + 2 * 1280 * 4;
constexpr size_t OFF_MODP = OFF_ROPE + (size_t)4096 * 16 * 2 * 4;
constexpr size_t OFF_MOD = OFF_MODP + (size_t)8 * 5 * 6144 * 4;
constexpr size_t OFF_GS2 = OFF_MOD + (size_t)5 * 6144 * 4;
constexpr size_t OFF_SSQ1 = OFF_GS2 + 4 * 1024 * 4;
constexpr size_t OFF_SUM = OFF_SSQ1 + (size_t)TT * 10 * 4;
constexpr size_t OFF_SSQ2 = OFF_SUM + (size_t)2 * 136 * 1280 * 2 * 4;
constexpr size_t OFF_H1 = OFF_SSQ2 + (size_t)TL * 16 * 4;
constexpr size_t OFF_Z = OFF_H1 + (size_t)TT * 1024 * 2;
constexpr size_t OFF_Q = OFF_Z + (size_t)TT * ZLD * 2;
constexpr size_t OFF_KB = OFF_Q + (size_t)NB * NH * S * QKD * 2;
constexpr size_t OFF_VT = OFF_KB + (size_t)NB * NH * NKEY * QKD * 2;
constexpr size_t WS_END = OFF_VT + (size_t)NB * NH * VD * NKEY * 2;
constexpr size_t OFF_BAR = WS_END;
constexpr size_t BAR_BYTES = 16384;
constexpr size_t OFF_HALO = OFF_BAR + BAR_BYTES;
constexpr size_t HALO_BYTES = (size_t)272 * 3 * 1280 * 2;
constexpr size_t OFF_CAR = OFF_HALO + HALO_BYTES;
constexpr size_t CAR_BYTES = (size_t)2 * 128 * 1280 * 4;
constexpr int CAR_FLAG_WORD = 3600;
constexpr size_t OFF_M1 = OFF_KB;
constexpr size_t OFF_FF = OFF_Z;
static_assert(WS_END + BAR_BYTES + HALO_BYTES + CAR_BYTES <= (size_t)256 * 1024 * 1024, "workspace too large");
static_assert((size_t)TL * 1024 * 2 <= WS_END - OFF_KB, "M1 overlay");
static_assert((size_t)TL * FFN * 2 <= (size_t)TT * ZLD * 2, "FF overlay");

constexpr int LDS_BYTES = 65536 + 4096;
constexpr int LDS_X = 65536;

struct P {
  const float *x, *c, *ctx, *c_ctx, *w_mod, *b_mod, *norm1_g, *w_in, *b_gate, *q_norm_g, *kv_norm_g, *w_uq, *w_ukv, *w_o_attn,
      *lru_conv_w, *lru_conv_b, *lru_w_a, *lru_b_a, *lru_w_x, *lru_b_x, *lru_lambda, *w_o_lru, *w_out, *norm2_g, *w_up,
      *ffn_conv_w, *ffn_conv_b, *w_down, *final_g;
  float* out;
  char* ws;
};

typedef __bf16 bf16x2_t __attribute__((ext_vector_type(2)));
typedef float f32x2_t __attribute__((ext_vector_type(2)));
DI unsigned pk2(float lo, float hi) { const f32x2_t v = {lo, hi}; return __builtin_bit_cast(unsigned, __builtin_convertvector(v, bf16x2_t)); }
DI float bflo(unsigned u) { return __uint_as_float(u << 16); }
DI float bfhi(unsigned u) { return __uint_as_float(u & 0xffff0000u); }
DI float sigm(float x) { return __builtin_amdgcn_rcpf(1.f + __expf(-x)); }
DI float gelu_tanh(float x) { float z = 0.7978845608f * (x + 0.044715f * x * x * x); float e = __expf(2.f * z); float t = 1.f - 2.f * __builtin_amdgcn_rcpf(e + 1.f); return 0.5f * x * (1.f + t); }
DI float wave_sum(float v) {
  v += __shfl_xor(v, 32); v += __shfl_xor(v, 16); v += __shfl_xor(v, 8); v += __shfl_xor(v, 4); v += __shfl_xor(v, 2); v += __shfl_xor(v, 1); return v;
}
DI void tile_mn(int t, int MT, int NT, int& m, int& n) {
  const int g = t / (8 * NT); const int rem = t - g * 8 * NT; int gsz = MT - 8 * g; gsz = gsz > 8 ? 8 : gsz;
  m = 8 * g + rem % gsz; n = rem / gsz;
}

DI bool tile_rect(int t, int MT, int NT, int& m, int& n) {
  const int xcd = t & 7, u = t >> 3, rq = u >> 4, wi = u & 15;
  const int q = ((rq >> 2) * 8 + xcd) * 4 + (rq & 3);
  const int hn = NT >> 1, g = q / hn, n2 = q - g * hn;
  m = 8 * g + (wi & 7); n = 2 * n2 + (wi >> 3);
  return m < MT;
}
DI int tile_rect_count(int MT, int NT) { const int qn = ((MT + 7) >> 3) * (NT >> 1); return ((qn + 31) >> 5) * 512; }
#define LAS3 __attribute__((address_space(3)))
#define GAS1 __attribute__((address_space(1)))
DI void glds16(const bf16_t* g, char* l) { __builtin_amdgcn_global_load_lds((const GAS1 void*)g, (LAS3 void*)(LAS3 char*)l, 16, 0, 0); }
DI __amdgpu_buffer_rsrc_t make_rsrc(const void* base) { return __builtin_amdgcn_make_buffer_rsrc((void*)base, 0, 0x7fffffff, 0x00020000); }
DI void bl16(__amdgpu_buffer_rsrc_t r, int voff, int soff, char* l) { __builtin_amdgcn_raw_ptr_buffer_load_lds(r, (LAS3 void*)(LAS3 char*)l, 16, voff, soff, 0, 0); }
#define BLD128(R, VO, SO) __builtin_bit_cast(u32x4, __builtin_amdgcn_raw_buffer_load_b128(R, VO, SO, 0))
#define BL16_4(R, VO, SO, L) do { LAS3 void* l_ = (LAS3 void*)(LAS3 char*)(L); \
    __builtin_amdgcn_raw_ptr_buffer_load_lds(R, l_, 16, (VO)[0], SO, 0, 0);    __builtin_amdgcn_raw_ptr_buffer_load_lds(R, l_, 16, (VO)[1], SO, 1024, 0); \
    __builtin_amdgcn_raw_ptr_buffer_load_lds(R, l_, 16, (VO)[2], SO, 2048, 0); __builtin_amdgcn_raw_ptr_buffer_load_lds(R, l_, 16, (VO)[3], SO, 3072, 0); } while (0)
template <bool PIPE, class AA>
DI void gemm_k(f32x4 (&acc)[4][4], const AA& aa, const bf16_t* __restrict__ Bt, int ldb, int K, char* lds, int tid) {
  const int lane = tid & 63, wid = tid >> 6, wr = wid >> 1, wc = wid & 1, fr = lane & 15, fq = lane >> 4;
  const int row0 = wid * 32 + (lane >> 3);
  const int cl = ((lane & 7) ^ ((lane >> 3) & 7)) * 8;
  const int ldst = wid * 4096 + lane * 16;
  const int nk = K >> 6;
  const __amdgpu_buffer_rsrc_t rsa = make_rsrc((const char*)aa.base() - 4096), rsb = make_rsrc((const char*)Bt - 4096);
  int voa[4], vob[4];
#pragma unroll
  for (int i = 0; i < 4; ++i) { voa[i] = aa.voff(row0 + 8 * i, cl) + 4096 - i * 1024; vob[i] = ((row0 + 8 * i) * ldb + cl) * 2 + 4096 - i * 1024; }
  const int ksa = aa.kstep();
  BL16_4(rsa, voa, 0, lds + ldst);
  BL16_4(rsb, vob, 0, lds + 16384 + ldst);
  const int aoff = (wr * 64 + fr) * 128, boff = 16384 + (wc * 64 + fr) * 128;
  const int x0 = ((0 + fq) ^ (fr & 7)) << 4, x1 = ((4 + fq) ^ (fr & 7)) << 4;
  for (int kt = 0; kt < nk; ++kt) {
    const int cur = (kt & 1) * 32768;
    asm volatile("s_waitcnt vmcnt(0)" ::: "memory");
    __syncthreads();
    if (kt + 1 < nk) {
      const int nxt = cur ^ 32768;
      BL16_4(rsa, voa, (kt + 1) * ksa, lds + nxt + ldst);
      BL16_4(rsb, vob, (kt + 1) * 128, lds + nxt + 16384 + ldst);
    }
    if (PIPE) {
      bf16x8 af[2][4], bfr[2][4];
#pragma unroll
      for (int m = 0; m < 4; ++m) af[0][m] = *(const bf16x8*)(lds + cur + aoff + m * 2048 + x0);
#pragma unroll
      for (int n = 0; n < 4; ++n) bfr[0][n] = *(const bf16x8*)(lds + cur + boff + n * 2048 + x0);
#pragma unroll
      for (int m = 0; m < 4; ++m) af[1][m] = *(const bf16x8*)(lds + cur + aoff + m * 2048 + x1);
#pragma unroll
      for (int n = 0; n < 4; ++n) bfr[1][n] = *(const bf16x8*)(lds + cur + boff + n * 2048 + x1);
#pragma unroll
      for (int kk = 0; kk < 2; ++kk)
#pragma unroll
        for (int m = 0; m < 4; ++m)
#pragma unroll
          for (int n = 0; n < 4; ++n) acc[m][n] = __builtin_amdgcn_mfma_f32_16x16x32_bf16(bfr[kk][n], af[kk][m], acc[m][n], 0, 0, 0);
      __builtin_amdgcn_sched_group_barrier(0x100, 8, 0);
#pragma unroll
      for (int i = 0; i < 8; ++i) { __builtin_amdgcn_sched_group_barrier(0x008, 2, 0); __builtin_amdgcn_sched_group_barrier(0x100, 1, 0); }
      __builtin_amdgcn_sched_group_barrier(0x008, 16, 0);
    } else {
#pragma unroll
      for (int kk = 0; kk < 2; ++kk) {
        const int xo = kk ? x1 : x0;
        bf16x8 af[4], bfr[4];
#pragma unroll
        for (int m = 0; m < 4; ++m) af[m] = *(const bf16x8*)(lds + cur + aoff + m * 2048 + xo);
#pragma unroll
        for (int n = 0; n < 4; ++n) bfr[n] = *(const bf16x8*)(lds + cur + boff + n * 2048 + xo);
#pragma unroll
        for (int m = 0; m < 4; ++m)
#pragma unroll
          for (int n = 0; n < 4; ++n) acc[m][n] = __builtin_amdgcn_mfma_f32_16x16x32_bf16(bfr[n], af[m], acc[m][n], 0, 0, 0);
      }
    }
  }
  __syncthreads();
}
struct LoadPlain {
  const bf16_t* A; int lda;
  DI const void* base() const { return A; }
  DI int voff(int row, int k) const { return (row * lda + k) * 2; }
  DI int kstep() const { return 128; }
};
struct LoadClamp {
  const bf16_t* A; int lda, m0;
  DI const void* base() const { return A; }
  DI int voff(int row, int k) const { int g = m0 + row; g = g < 0 ? 0 : (g > TL - 1 ? TL - 1 : g); return (g * lda + k) * 2; }
  DI int kstep() const { return 128; }
};
DI void zero_acc(f32x4 (&acc)[4][4]) {
#pragma unroll
  for (int m = 0; m < 4; ++m)
#pragma unroll
    for (int n = 0; n < 4; ++n) acc[m][n] = (f32x4){0.f, 0.f, 0.f, 0.f};
}


#define XB_TMO      128
#define XB_XCNT(j)  (256  + 64 * (j))
#define XB_XSUB(j)  (1280 + 64 * (j))
#define XB_XGEN(j)  (2304 + 64 * (j))
#define XB_TOP      3328
#define XB_TOPGEN   3392
#define XCD_BAR_WORDS 3456
#define XB_SPIN_CAP (1u << 18)
#define LAS __attribute__((address_space(3)))
DI unsigned xb_ld(unsigned* p) { return __hip_atomic_load(p, __ATOMIC_RELAXED, __HIP_MEMORY_SCOPE_AGENT); }
DI unsigned xb_add(unsigned* p, unsigned v) { return __hip_atomic_fetch_add(p, v, __ATOMIC_RELAXED, __HIP_MEMORY_SCOPE_AGENT); }
DI unsigned xb_xcc_id() { return (unsigned)__builtin_amdgcn_s_getreg((3 << 11) | 20) & 0xFu; }
#define XB_SPIN(cond, bar) do { unsigned _sp = 0; while (cond) { __builtin_amdgcn_s_sleep(1); \
    if ((++_sp & 255u) == 0u) { if (xb_ld(&(bar)[XB_TMO])) break; if (_sp > XB_SPIN_CAP) { atomicAdd(&(bar)[XB_TMO], 1u); break; } } } } while (0)
struct XcdBarrier { unsigned* bar; unsigned x; volatile LAS unsigned* st; };
DI XcdBarrier xcd_barrier_post(unsigned* bar, volatile LAS unsigned* st) {
  XcdBarrier b; b.bar = bar; b.x = xb_xcc_id(); b.st = st;
  if (threadIdx.x == 0) (void)xb_add(&bar[XB_XCNT(b.x)], 1u);
  return b;
}
DI void xcd_barrier_complete(unsigned* bar, unsigned x, unsigned& nloc, unsigned& nx) {
  const unsigned G = gridDim.x * gridDim.y * gridDim.z;
  unsigned sum, cnt, mine, sp = 0u;
  for (;;) {
    sum = 0u; cnt = 0u; mine = 0u;
#pragma unroll
    for (unsigned j = 0; j < 16; ++j) { const unsigned c = xb_ld(&bar[XB_XCNT(j)]); sum += c; cnt += (c > 0u) ? 1u : 0u; mine = (j == x) ? c : mine; }
    if (sum == G) break;
    __builtin_amdgcn_s_sleep(1);
    if ((++sp & 255u) == 0u) { if (xb_ld(&bar[XB_TMO])) break; if (sp > XB_SPIN_CAP) { atomicAdd(&bar[XB_TMO], 1u); break; } }
  }
  nloc = mine > 0u ? mine : 1u; nx = cnt > 0u ? cnt : 1u;
}
DI void xcd_barrier(const XcdBarrier& b) {
  asm volatile("s_waitcnt vmcnt(0)" ::: "memory");
  __syncthreads();
  if (threadIdx.x == 0) {
    unsigned* bar = b.bar;
    __builtin_amdgcn_s_waitcnt(0);
    unsigned nloc = b.st[0], nx = b.st[1];
    if (nloc == 0u) { xcd_barrier_complete(bar, b.x, nloc, nx); b.st[0] = nloc; b.st[1] = nx; }
    const unsigned old = xb_add(&bar[XB_XSUB(b.x)], 1u);
    const unsigned gen = old / nloc;
    if (old + 1u == (gen + 1u) * nloc) {
      __builtin_amdgcn_fence(__ATOMIC_RELEASE, "agent");
      asm volatile("s_waitcnt vmcnt(0)" ::: "memory");
      const unsigned og = xb_add(&bar[XB_TOP], 1u);
      const unsigned tg = og / nx;
      if (og + 1u == (tg + 1u) * nx) xb_add(&bar[XB_TOPGEN], 1u);
      else XB_SPIN(xb_ld(&bar[XB_TOPGEN]) == tg, bar);
      __builtin_amdgcn_fence(__ATOMIC_ACQUIRE, "agent");
      xb_add(&bar[XB_XGEN(b.x)], 1u);
      asm volatile("s_waitcnt vmcnt(0)" ::: "memory");
    } else {
      XB_SPIN(xb_ld(&bar[XB_XGEN(b.x)]) == gen, bar);
      __builtin_amdgcn_fence(__ATOMIC_ACQUIRE, "agent");
      asm volatile("s_waitcnt vmcnt(0)" ::: "memory");
    }
  }
  __syncthreads();
}

DI int map_row(int mode, int aux, int n) {
  if (mode == 0) return n;
  if (mode == 1) {
    if (n < 640) return n;
    if (n < 672) return ZC_KR + (n - 640);
    if (n < 3232) return n - 32;
    return ZLD + (n - 3232);
  }
  if (mode == 2) {
    const int cb = aux >> 2, sub = aux & 3;
    return (cb * 4 + (n >> 5)) * 128 + ((n >> 4) & 1) * 64 + sub * 16 + (n & 15);
  }
  const int gate = n >= FFN ? 1 : 0, ch = n - gate * FFN;
  return (ch >> 6) * 128 + ((ch >> 5) & 1) * 64 + gate * 32 + (ch & 31);
}
DI void transpose_tile(const float* __restrict__ src, int K, int N, int kt, int nt, bf16_t* __restrict__ dst, int dst_ld, int mode, int aux,
                       const float* __restrict__ kscale, char* lds, int tid) {
  float* T = (float*)lds;
  const int n4 = (tid & 15) * 4, nn = nt * 64 + n4;
#pragma unroll
  for (int i = 0; i < 4; ++i) {
    const int kl = i * 16 + (tid >> 4), k = kt * 64 + kl;
    f32x4 v = (nn < N) ? *(const f32x4*)(src + (size_t)k * N + nn) : (f32x4){0.f, 0.f, 0.f, 0.f};
    if (kscale) v *= kscale[k];
    T[kl * 65 + n4] = v[0]; T[kl * 65 + n4 + 1] = v[1]; T[kl * 65 + n4 + 2] = v[2]; T[kl * 65 + n4 + 3] = v[3];
  }
  __syncthreads();
  const int nl = tid >> 2, kq = tid & 3, n = nt * 64 + nl;
  if (n < N) {
    const int drow = map_row(mode, aux, n);
    unsigned w[8];
#pragma unroll
    for (int e = 0; e < 8; ++e) w[e] = pk2(T[(kq * 16 + 2 * e) * 65 + nl], T[(kq * 16 + 2 * e + 1) * 65 + nl]);
    bf16_t* dp = dst + (size_t)drow * dst_ld + kt * 64 + kq * 16;
    *(u32x4*)dp = (u32x4){w[0], w[1], w[2], w[3]};
    *(u32x4*)(dp + 8) = (u32x4){w[4], w[5], w[6], w[7]};
  }
  __syncthreads();
}

constexpr int TRN0 = 16 * 83, TRN1 = 6 * 12, TRN2 = 4 * 16, TRN45 = 160, TRN3 = 8 * 16, TRN6 = 20 * 16, TRN7 = 16 * 16, TRN8 = 16 * 88, TRN9 = 44 * 16;
constexpr int TR_EARLY = TRN0 + TRN1 + TRN2 + TRN45;
constexpr int TR_ALL = TR_EARLY + TRN3 + TRN6 + TRN7 + TRN8 + TRN9;
DI void transpose_job(const P& p, int t, char* lds, int tid) {
  if (t < TRN0) { transpose_tile(p.w_in, 1024, IN_DIM, t % 16, t / 16, (bf16_t*)(p.ws + OFF_WIN), 1024, 1, 0, nullptr, lds, tid); return; }
  t -= TRN0;
  if (t < TRN1) { transpose_tile(p.w_uq, 384, 768, t % 6, t / 6, (bf16_t*)(p.ws + OFF_WUQ), 384, 0, 0, p.q_norm_g, lds, tid); return; }
  t -= TRN1;
  if (t < TRN2) { transpose_tile(p.w_ukv, 256, 1024, t % 4, t / 4, (bf16_t*)(p.ws + OFF_WUKV), 256, 0, 0, p.kv_norm_g, lds, tid); return; }
  t -= TRN2;
  if (t < TRN45) {
    const int gate = t >= 80 ? 1 : 0; const int tt = t - gate * 80;
    const int mat = tt >> 2, sub4 = tt & 3;
    const int dir = mat / 10, cb = mat % 10;
    const float* src = (gate ? p.lru_w_x : p.lru_w_a) + (size_t)mat * 128 * 128;
    transpose_tile(src, 128, 128, sub4 & 1, sub4 >> 1, (bf16_t*)(p.ws + OFF_GATES), 128, 2, cb * 4 + dir * 2 + gate, nullptr, lds, tid); return;
  }
  t -= TRN45;
  if (t < TRN3) { transpose_tile(p.w_o_attn, 512, 1024, t % 8, t / 8, (bf16_t*)(p.ws + OFF_WOA), 512, 0, 0, nullptr, lds, tid); return; }
  t -= TRN3;
  if (t < TRN6) { transpose_tile(p.w_o_lru, 1280, 1024, t % 20, t / 20, (bf16_t*)(p.ws + OFF_WOL), 1280, 0, 0, nullptr, lds, tid); return; }
  t -= TRN6;
  if (t < TRN7) { transpose_tile(p.w_out, 1024, 1024, t % 16, t / 16, (bf16_t*)(p.ws + OFF_WOUT), 1024, 0, 0, nullptr, lds, tid); return; }
  t -= TRN7;
  if (t < TRN8) { transpose_tile(p.w_up, 1024, 2 * FFN, t % 16, t / 16, (bf16_t*)(p.ws + OFF_WUP), 1024, 3, 0, nullptr, lds, tid); return; }
  t -= TRN8;
  transpose_tile(p.w_down, FFN, 1024, t % 44, t / 44, (bf16_t*)(p.ws + OFF_WD), FFN, 0, 0, nullptr, lds, tid);
}

DI void phase0(const P& p, char* lds, int tid) {
  bf16_t* WIN = (bf16_t*)(p.ws + OFF_WIN);
  constexpr int N_MODP = 384;
  constexpr int N_TR = TR_EARLY;
  constexpr int N_MISC = 64 + 3 + 12;
  constexpr int N_ITEMS = N_MODP + N_TR + N_MISC;
  for (int it = blockIdx.x; it < N_ITEMS; it += gridDim.x) {
    if (it < N_MODP) {
      const int ng = it % 48, pk = it / 48;
      float* sv = (float*)lds;
      float* red = sv + 640;
      for (int i = tid; i < 640; i += 256) {
        const int bi = i >> 7, kk = i & 127, k = pk * 128 + kk;
        const float cv = bi < 4 ? p.c[bi * 1024 + k] : p.c_ctx[k];
        sv[i] = cv * sigm(cv);
      }
      __syncthreads();
      const int col = tid & 127, kh = tid >> 7;
      float a0 = 0.f, a1 = 0.f, a2 = 0.f, a3 = 0.f, a4 = 0.f;
      const float* wp = p.w_mod + (size_t)(pk * 128 + kh * 64) * 6144 + ng * 128 + col;
      const float* svh = sv + kh * 64;
#pragma unroll 16
      for (int kk = 0; kk < 64; ++kk) {
        const float w = wp[(size_t)kk * 6144];
        a0 += svh[kk] * w; a1 += svh[128 + kk] * w; a2 += svh[256 + kk] * w; a3 += svh[384 + kk] * w; a4 += svh[512 + kk] * w;
      }
      if (kh == 1) { red[col] = a0; red[128 + col] = a1; red[256 + col] = a2; red[384 + col] = a3; red[512 + col] = a4; }
      __syncthreads();
      if (kh == 0) {
        float* mp = (float*)(p.ws + OFF_MODP) + (size_t)(pk * 5) * 6144 + ng * 128 + col;
        mp[0] = a0 + red[col]; mp[6144] = a1 + red[128 + col]; mp[2 * 6144] = a2 + red[256 + col]; mp[3 * 6144] = a3 + red[384 + col]; mp[4 * 6144] = a4 + red[512 + col];
      }
      __syncthreads();
    } else if (it < N_MODP + N_TR) {
      transpose_job(p, it - N_MODP, lds, tid);
    } else {
      int t = it - N_MODP - N_TR;
      if (t < 64) {
#pragma unroll
        for (int e = 0; e < 4; ++e) {
          const int idx = t * 1024 + e * 256 + tid; const int s = idx >> 4, i = idx & 15;
          const float pos = (float)((i < 8) ? (s >> 6) : (s & 63));
          const float inv = 1.0f / powf(10000.0f, (float)(2 * (i & 7)) / 16.0f);
          const float ang = pos * inv;
          float* rp = (float*)(p.ws + OFF_ROPE) + (size_t)idx * 2;
          rp[0] = cosf(ang); rp[1] = sinf(ang);
        }
      } else if (t < 67) {
        const int idx0 = (t - 64) * 1024;
#pragma unroll
        for (int e = 0; e < 4; ++e) {
          const int idx = idx0 + e * 256 + tid;
          if (idx < 2 * LW) ((float*)(p.ws + OFF_SP))[idx] = log1pf(expf(-p.lru_lambda[idx]));
        }
      } else {
        const int idx0 = (t - 67) * 1024;
#pragma unroll
        for (int e = 0; e < 4; ++e) {
          const int idx = idx0 + e * 256 + tid;
          *(u32x4*)((char*)(WIN + (size_t)3232 * 1024) + (size_t)idx * 16) = (u32x4){0u, 0u, 0u, 0u};
        }
      }
    }
  }
}

DI void phase1(const P& p, char* lds, int tid) {
  const float* MODP = (const float*)(p.ws + OFF_MODP);
  const int lane = tid & 63, wid = tid >> 6;
  for (int it = blockIdx.x; it < 544 + 34 + (TR_ALL - TR_EARLY); it += gridDim.x) {
    if (it >= 544 + 34) { transpose_job(p, TR_EARLY + (it - 578), lds, tid); continue; }
    if (it < 544) {
      const int t0 = it * 32;
      const int bi = t0 < TL ? (t0 >> 12) : 4;
      float* gs = (float*)lds; float* sh = gs + 1024;
      {
        const int k = tid * 4;
        f32x4 a = *(const f32x4*)(p.b_mod + k), b = *(const f32x4*)(p.b_mod + 1024 + k);
#pragma unroll
        for (int pp = 0; pp < 8; ++pp) {
          a += *(const f32x4*)(MODP + (size_t)(pp * 5 + bi) * 6144 + k);
          b += *(const f32x4*)(MODP + (size_t)(pp * 5 + bi) * 6144 + 1024 + k);
        }
        const f32x4 g = *(const f32x4*)(p.norm1_g + k);
        *(f32x4*)(sh + k) = a;
        *(f32x4*)(gs + k) = g * (1.f + b);
      }
      __syncthreads();
      for (int tt = 0; tt < 8; ++tt) {
        const int t = t0 + wid * 8 + tt;
        const float* src = t < TL ? p.x + (size_t)t * 1024 : p.ctx + (size_t)(t - TL) * 1024;
        f32x4 v[4]; float ss = 0.f;
#pragma unroll
        for (int i = 0; i < 4; ++i) { v[i] = *(const f32x4*)(src + i * 256 + lane * 4); ss += v[i][0] * v[i][0] + v[i][1] * v[i][1] + v[i][2] * v[i][2] + v[i][3] * v[i][3]; }
        ss = wave_sum(ss);
        const float rs = rsqrtf(ss * (1.f / 1024.f) + EPS);
        bf16_t* dp = (bf16_t*)(p.ws + OFF_H1) + (size_t)t * 1024;
#pragma unroll
        for (int i = 0; i < 4; ++i) {
          const int k = i * 256 + lane * 4;
          const f32x4 g = *(const f32x4*)(gs + k), s = *(const f32x4*)(sh + k);
          const f32x4 y = v[i] * rs * g + s;
          *(u32x2*)(dp + k) = (u32x2){pk2(y[0], y[1]), pk2(y[2], y[3])};
        }
      }
      __syncthreads();
    } else {
      const int fi = it - 544;
#pragma unroll
      for (int e = 0; e < 4; ++e) {
        const int idx = fi * 1024 + tid * 4 + e;
        if (idx < 30720) {
          const int bi = idx / 6144, n = idx - bi * 6144;
          float a = p.b_mod[n];
#pragma unroll
          for (int pp = 0; pp < 8; ++pp) a += MODP[(size_t)(pp * 5 + bi) * 6144 + n];
          ((float*)(p.ws + OFF_MOD))[idx] = a;
        } else {
          const int i2 = idx - 30720, b = i2 >> 10, k = i2 & 1023;
          float a = p.b_mod[4096 + k];
#pragma unroll
          for (int pp = 0; pp < 8; ++pp) a += MODP[(size_t)(pp * 5 + b) * 6144 + 4096 + k];
          ((float*)(p.ws + OFF_GS2))[i2] = p.norm2_g[k] * (1.f + a);
        }
      }
    }
  }
}

DI void phase2(const P& p, char* lds, int tid) {
  const int lane = tid & 63, wid = tid >> 6, wr = wid >> 1, wc = wid & 1, fr = lane & 15, fq = lane >> 4;
  const bf16_t* H1 = (const bf16_t*)(p.ws + OFF_H1);
  const bf16_t* WIN = (const bf16_t*)(p.ws + OFF_WIN);
  bf16_t* Z = (bf16_t*)(p.ws + OFF_Z);
  float* SSQ1 = (float*)(p.ws + OFF_SSQ1);
  for (int t = blockIdx.x; t < tile_rect_count(136, NT_Z); t += gridDim.x) {
    int m, n; if (!tile_rect(t, 136, NT_Z, m, n)) continue;
    if (m >= 128 && (n < 3 || (n >= 15 && n < 25))) continue;
    f32x4 acc[4][4]; zero_acc(acc);
    LoadPlain la{H1 + (size_t)m * 128 * 1024, 1024};
    gemm_k<true>(acc, la, WIN + (size_t)n * 128 * 1024, 1024, 1024, lds, tid);
#pragma unroll
    for (int mm = 0; mm < 4; ++mm) {
      const int row = m * 128 + wr * 64 + mm * 16 + fr;
      float ss = 0.f;
#pragma unroll
      for (int nn = 0; nn < 4; ++nn) {
        const f32x4 v = acc[mm][nn];
        ss += v[0] * v[0] + v[1] * v[1] + v[2] * v[2] + v[3] * v[3];
        const u32x2 pv = (u32x2){pk2(v[0], v[1]), pk2(v[2], v[3])};
        *(u32x2*)(Z + (size_t)row * ZLD + n * 128 + wc * 64 + nn * 16 + fq * 4) = pv;
        if (n >= 5 && n < 15) {
          const int r6 = row & 63;
          if (r6 == 0 || r6 >= 62) {
            const int slot = r6 == 0 ? 0 : r6 - 61;
            *(u32x2*)((bf16_t*)(p.ws + OFF_HALO) + ((size_t)(row >> 6) * 3 + slot) * LW + (n - 5) * 128 + wc * 64 + nn * 16 + fq * 4) = pv;
          }
        }
      }
      if (n < 5) {
        ss += __shfl_xor(ss, 16); ss += __shfl_xor(ss, 32);
        if (fq == 0) SSQ1[(size_t)row * 10 + n * 2 + wc] = ss;
      }
    }
  }
}

DI void unpack8(const u32x4 v, float (&o)[8]) {
  o[0] = bflo(v[0]); o[1] = bfhi(v[0]); o[2] = bflo(v[1]); o[3] = bfhi(v[1]); o[4] = bflo(v[2]); o[5] = bfhi(v[2]); o[6] = bflo(v[3]); o[7] = bfhi(v[3]);
}
DI void conv_chunks(const P& p, int c, int tid) {
  bf16_t* Z = (bf16_t*)(p.ws + OFF_Z);
  const bf16_t* HALO = (const bf16_t*)(p.ws + OFF_HALO);
  if (tid >= 160) return;
  const int ch = tid * 8;
  float w[4][8], bias[8];
#pragma unroll
  for (int kk = 0; kk < 4; ++kk) {
    const f32x4 a = *(const f32x4*)(p.lru_conv_w + kk * LW + ch), b = *(const f32x4*)(p.lru_conv_w + kk * LW + ch + 4);
    w[kk][0] = a[0]; w[kk][1] = a[1]; w[kk][2] = a[2]; w[kk][3] = a[3]; w[kk][4] = b[0]; w[kk][5] = b[1]; w[kk][6] = b[2]; w[kk][7] = b[3];
  }
  { const f32x4 a = *(const f32x4*)(p.lru_conv_b + ch), b = *(const f32x4*)(p.lru_conv_b + ch + 4);
    bias[0] = a[0]; bias[1] = a[1]; bias[2] = a[2]; bias[3] = a[3]; bias[4] = b[0]; bias[5] = b[1]; bias[6] = b[2]; bias[7] = b[3]; }
  {
    const int r0 = c * 64;
    int seq0, seqlen;
    if (r0 < TL) { seq0 = r0 & ~4095; seqlen = S; } else { seq0 = TL + ((r0 - TL) & ~255); seqlen = CL; }
    const u32x4 zero4 = (u32x4){0u, 0u, 0u, 0u};
    u32x4 xm2 = zero4, xm1 = zero4;
    if (r0 > seq0) { xm2 = *(const u32x4*)(HALO + ((size_t)(c - 1) * 3 + 1) * LW + ch); xm1 = *(const u32x4*)(HALO + ((size_t)(c - 1) * 3 + 2) * LW + ch); }
    u32x4 nxt = zero4;
    if (r0 + 64 < seq0 + seqlen) nxt = *(const u32x4*)(HALO + ((size_t)(c + 1) * 3 + 0) * LW + ch);
    bf16_t* zp = Z + (size_t)r0 * ZLD + ZC_XB + ch;
#pragma unroll 1
    for (int bt = 0; bt < 4; ++bt) {
      u32x4 cur[17];
#pragma unroll
      for (int i = 0; i < 16; ++i) cur[i] = *(const u32x4*)(zp + (size_t)(bt * 16 + i) * ZLD);
      cur[16] = (bt < 3) ? *(const u32x4*)(zp + (size_t)(bt * 16 + 16) * ZLD) : nxt;
#pragma unroll
      for (int i = 0; i < 16; ++i) {
        float a[8], b[8], cc[8], d[8], o[8];
        unpack8(xm2, a); unpack8(xm1, b); unpack8(cur[i], cc); unpack8(cur[i + 1], d);
#pragma unroll
        for (int e = 0; e < 8; ++e) o[e] = bias[e] + w[0][e] * a[e] + w[1][e] * b[e] + w[2][e] * cc[e] + w[3][e] * d[e];
        *(u32x4*)(zp + (size_t)(bt * 16 + i) * ZLD) = (u32x4){pk2(o[0], o[1]), pk2(o[2], o[3]), pk2(o[4], o[5]), pk2(o[6], o[7])};
        xm2 = xm1; xm1 = cur[i];
      }
    }
  }
}

template <int PASS>
DI void gates_tile(const P& p, int mt, int nt, char* lds, int tid) {
  const int lane = tid & 63, wid = tid >> 6, wr = wid >> 1, wc = wid & 1, fr = lane & 15, fq = lane >> 4;
  bf16_t* Z = (bf16_t*)(p.ws + OFF_Z);
  const float* SP = (const float*)(p.ws + OFF_SP);
  float* SUM = (float*)(p.ws + OFF_SUM);
  float* XS = (float*)(lds + LDS_X);
  float* TCAR = (float*)(lds + LDS_X + 2048);
  const int m0 = mt * 128;
  const int cb = nt >> 2;
  if (PASS == 2) {
    if (tid < 64) TCAR[tid] = ((const float*)(p.ws + OFF_CAR))[((size_t)(tid >> 5) * 128 + mt) * LW + nt * 32 + (tid & 31)];
  }
  f32x4 acc[4][4]; zero_acc(acc);
  LoadPlain la{Z + (size_t)m0 * ZLD + ZC_XB + cb * 128, ZLD};
  gemm_k<false>(acc, la, (const bf16_t*)(p.ws + OFF_GATES) + (size_t)nt * 128 * 128, 128, 128, lds, tid);
  {
    const int chl0 = wc * 16 + fq * 4, ch = nt * 32 + chl0;
    f32x4 xc[4];
#pragma unroll
    for (int mm = 0; mm < 4; ++mm) {
      const u32x2 xv = *(const u32x2*)(Z + (size_t)(m0 + wr * 64 + mm * 16 + fr) * ZLD + ZC_XB + ch);
      xc[mm] = (f32x4){bflo(xv[0]), bfhi(xv[0]), bflo(xv[1]), bfhi(xv[1])};
    }
    float* LAf = (float*)lds; float* Uf = LAf + 4096; float* LAb = LAf + 8192; float* Ub = LAf + 12288;
    {
      const f32x4 baf = *(const f32x4*)(p.lru_b_a + ch) * -1.4426950408889634f, bxf = *(const f32x4*)(p.lru_b_x + ch) * -1.4426950408889634f,
                  spf = *(const f32x4*)(SP + ch) * (-8.f * 1.4426950408889634f);
#pragma unroll
      for (int mm = 0; mm < 4; ++mm) {
        const int rl = wr * 64 + mm * 16 + fr;
        f32x4 laf, uf;
#pragma unroll
        for (int j = 0; j < 4; ++j) {
          const float er = 1.f + __builtin_amdgcn_exp2f(__builtin_fmaf(acc[mm][0][j], -1.4426950408889634f, baf[j]));
          const float ei = 1.f + __builtin_amdgcn_exp2f(__builtin_fmaf(acc[mm][1][j], -1.4426950408889634f, bxf[j]));
          const float inv = __builtin_amdgcn_rcpf(er * ei);
          const float rf = inv * ei, xf = inv * er;
          const float a = __builtin_amdgcn_exp2f(rf * spf[j]);
          laf[j] = a;
          uf[j] = __builtin_amdgcn_sqrtf(fmaxf(1.f - a * a, 0.f)) * xf * xc[mm][j];
        }
        *(f32x4*)(LAf + rl * 32 + chl0) = laf; *(f32x4*)(Uf + rl * 32 + chl0) = uf;
      }
    }
    {
      const f32x4 bab = *(const f32x4*)(p.lru_b_a + LW + ch) * -1.4426950408889634f, bxb = *(const f32x4*)(p.lru_b_x + LW + ch) * -1.4426950408889634f,
                  spb = *(const f32x4*)(SP + LW + ch) * (-8.f * 1.4426950408889634f);
#pragma unroll
      for (int mm = 0; mm < 4; ++mm) {
        const int rl = wr * 64 + mm * 16 + fr;
        f32x4 lab, ub;
#pragma unroll
        for (int j = 0; j < 4; ++j) {
          const float er = 1.f + __builtin_amdgcn_exp2f(__builtin_fmaf(acc[mm][2][j], -1.4426950408889634f, bab[j]));
          const float ei = 1.f + __builtin_amdgcn_exp2f(__builtin_fmaf(acc[mm][3][j], -1.4426950408889634f, bxb[j]));
          const float inv = __builtin_amdgcn_rcpf(er * ei);
          const float rb = inv * ei, xb = inv * er;
          const float a = __builtin_amdgcn_exp2f(rb * spb[j]);
          lab[j] = a;
          ub[j] = __builtin_amdgcn_sqrtf(fmaxf(1.f - a * a, 0.f)) * xb * xc[mm][j];
        }
        *(f32x4*)(LAb + rl * 32 + chl0) = lab; *(f32x4*)(Ub + rl * 32 + chl0) = ub;
      }
    }
  }
  __syncthreads();
  const int chain = tid & 63, dir = chain >> 5, chl = chain & 31, seg = tid >> 6;
  float* LA = (float*)lds + dir * 8192; float* U = LA + 4096;
  const int rbase = dir ? 127 - seg * 32 : seg * 32, rstep = dir ? -1 : 1;
  float hh = 0.f, cum = 1.f;
#pragma unroll 1
  for (int hf = 0; hf < 2; ++hf) {
    float la_[16], u_[16];
#pragma unroll
    for (int i = 0; i < 16; ++i) { const int rl = rbase + rstep * (hf * 16 + i); la_[i] = LA[rl * 32 + chl]; u_[i] = U[rl * 32 + chl]; }
#pragma unroll
    for (int i = 0; i < 16; ++i) {
      cum *= la_[i]; hh = la_[i] * hh + u_[i];
      if (PASS == 2) { const int rl = rbase + rstep * (hf * 16 + i); LA[rl * 32 + chl] = cum; U[rl * 32 + chl] = hh; }
    }
  }
  XS[((dir * 4 + seg) * 32 + chl) * 2] = cum; XS[((dir * 4 + seg) * 32 + chl) * 2 + 1] = hh;
  __syncthreads();
  float cy = (PASS == 2) ? TCAR[chain] : 0.f;
  float ccum = 1.f;
#pragma unroll
  for (int s2 = 0; s2 < 3; ++s2) {
    if (s2 < seg) { const float cs = XS[((dir * 4 + s2) * 32 + chl) * 2], hs = XS[((dir * 4 + s2) * 32 + chl) * 2 + 1]; cy = hs + cs * cy; ccum *= cs; }
  }
  if (PASS == 1) {
    if (seg == 3) {
      float* sp = SUM + (((size_t)dir * 136 + mt) * LW + nt * 32 + chl) * 2;
      sp[0] = ccum * cum; sp[1] = hh + cum * cy;
    }
    __syncthreads();
  } else {
#pragma unroll 8
    for (int i = 0; i < 32; ++i) { const int rl = rbase + rstep * i; U[rl * 32 + chl] += LA[rl * 32 + chl] * cy; }
    __syncthreads();
    {
      const int rl = tid >> 1, c16 = (tid & 1) * 16;
      const float* Uf = (const float*)lds + 4096; const float* Ub = (const float*)lds + 12288;
#pragma unroll 1
      for (int hf = 0; hf < 2; ++hf) {
        bf16_t* yp = Z + (size_t)(m0 + rl) * ZLD + ZC_YB + nt * 32 + c16 + hf * 8;
        const u32x4 y0 = *(const u32x4*)yp;
        const f32x4 fa = *(const f32x4*)(Uf + rl * 32 + c16 + hf * 8), fb = *(const f32x4*)(Uf + rl * 32 + c16 + hf * 8 + 4);
        const f32x4 ba = *(const f32x4*)(Ub + rl * 32 + c16 + hf * 8), bb = *(const f32x4*)(Ub + rl * 32 + c16 + hf * 8 + 4);
        u32x4 o;
        o[0] = pk2((fa[0] + ba[0]) * gelu_tanh(bflo(y0[0])), (fa[1] + ba[1]) * gelu_tanh(bfhi(y0[0])));
        o[1] = pk2((fa[2] + ba[2]) * gelu_tanh(bflo(y0[1])), (fa[3] + ba[3]) * gelu_tanh(bfhi(y0[1])));
        o[2] = pk2((fb[0] + bb[0]) * gelu_tanh(bflo(y0[2])), (fb[1] + bb[1]) * gelu_tanh(bfhi(y0[2])));
        o[3] = pk2((fb[2] + bb[2]) * gelu_tanh(bflo(y0[3])), (fb[3] + bb[3]) * gelu_tanh(bfhi(y0[3])));
        *(u32x4*)yp = o;
      }
    }
    __syncthreads();
  }
}

DI void row_bk(int row, int& b, int& key) {
  if (row < TL) { b = row >> 12; key = row & 4095; } else { const int r2 = row - TL; b = r2 >> 8; key = S + (r2 & 255); }
}

DI void kv_tile(const P& p, int m, int h, char* lds, int tid) {
  const int lane = tid & 63, wid = tid >> 6, wr = wid >> 1, wc = wid & 1, fr = lane & 15, fq = lane >> 4;
  const bf16_t* Z = (const bf16_t*)(p.ws + OFF_Z);
  const float* SSQ1 = (const float*)(p.ws + OFF_SSQ1);
  bf16_t* KB = (bf16_t*)(p.ws + OFF_KB); bf16_t* VT = (bf16_t*)(p.ws + OFF_VT);
  f32x4 acc[4][4]; zero_acc(acc);
  LoadPlain la{Z + (size_t)m * 128 * ZLD + ZC_KVL, ZLD};
  gemm_k<false>(acc, la, (const bf16_t*)(p.ws + OFF_WUKV) + (size_t)h * 128 * 256, 256, 256, lds, tid);
#pragma unroll
  for (int mm = 0; mm < 4; ++mm) {
    const int row = m * 128 + wr * 64 + mm * 16 + fr;
    const float* sq = SSQ1 + (size_t)row * 10 + 6;
    const float rs = rsqrtf((sq[0] + sq[1] + sq[2] + sq[3]) * (1.f / 256.f) + EPS);
    int b, key; row_bk(row, b, key);
#pragma unroll
    for (int nn = 0; nn < 4; ++nn) {
      const f32x4 v = acc[mm][nn] * rs;
      const int d = nn * 16 + fq * 4;
      if (wc == 0) {
        *(u32x2*)(KB + ((size_t)(b * NH + h) * NKEY + key) * QKD + d) = (u32x2){pk2(v[0], v[1]), pk2(v[2], v[3])};
      } else {
        bf16_t* vp = VT + ((size_t)(b * NH + h) * VD + d) * NKEY + key;
        const unsigned w0 = pk2(v[0], v[1]), w1 = pk2(v[2], v[3]);
        vp[0] = (bf16_t)(w0 & 0xffffu); vp[NKEY] = (bf16_t)(w0 >> 16); vp[2 * NKEY] = (bf16_t)(w1 & 0xffffu); vp[3 * NKEY] = (bf16_t)(w1 >> 16);
      }
    }
  }
  {
    const int rl = tid >> 1, half = tid & 1, row = m * 128 + rl;
    int b, key; row_bk(row, b, key);
    const bf16_t* kr = Z + (size_t)row * ZLD + ZC_KR + half * 8;
    const u32x4 a1 = *(const u32x4*)kr, a2 = *(const u32x4*)(kr + 16);
    float x1[8] = {bflo(a1[0]), bfhi(a1[0]), bflo(a1[1]), bfhi(a1[1]), bflo(a1[2]), bfhi(a1[2]), bflo(a1[3]), bfhi(a1[3])};
    float x2[8] = {bflo(a2[0]), bfhi(a2[0]), bflo(a2[1]), bfhi(a2[1]), bflo(a2[2]), bfhi(a2[2]), bflo(a2[3]), bfhi(a2[3])};
    float o1[8], o2[8];
    if (row < TL) {
      const float* rp = (const float*)(p.ws + OFF_ROPE) + ((size_t)key * 16 + half * 8) * 2;
#pragma unroll
      for (int e = 0; e < 8; ++e) { const float cs = rp[2 * e], sn = rp[2 * e + 1]; o1[e] = x1[e] * cs - x2[e] * sn; o2[e] = x2[e] * cs + x1[e] * sn; }
    } else {
#pragma unroll
      for (int e = 0; e < 8; ++e) { o1[e] = x1[e]; o2[e] = x2[e]; }
    }
    bf16_t* kp = KB + ((size_t)(b * NH + h) * NKEY + key) * QKD + 64 + half * 8;
    *(u32x4*)kp = (u32x4){pk2(o1[0], o1[1]), pk2(o1[2], o1[3]), pk2(o1[4], o1[5]), pk2(o1[6], o1[7])};
    *(u32x4*)(kp + 16) = (u32x4){pk2(o2[0], o2[1]), pk2(o2[2], o2[3]), pk2(o2[4], o2[5]), pk2(o2[6], o2[7])};
  }
}

DI void q_tile(const P& p, int m, int n, char* lds, int tid) {
  const int lane = tid & 63, wid = tid >> 6, wr = wid >> 1, wc = wid & 1, fr = lane & 15, fq = lane >> 4;
  const bf16_t* Z = (const bf16_t*)(p.ws + OFF_Z);
  const float* SSQ1 = (const float*)(p.ws + OFF_SSQ1);
  bf16_t* Q = (bf16_t*)(p.ws + OFF_Q);
  f32x4 acc[4][4]; zero_acc(acc);
  LoadPlain la{Z + (size_t)m * 128 * ZLD + ZC_QL, ZLD};
  gemm_k<false>(acc, la, (const bf16_t*)(p.ws + OFF_WUQ) + (size_t)n * 128 * 384, 384, 384, lds, tid);
  const float qscale = 0.10206207261596577f * 1.4426950408889634f;
#pragma unroll
  for (int mm = 0; mm < 4; ++mm) {
    const int row = m * 128 + wr * 64 + mm * 16 + fr;
    const float* sq = SSQ1 + (size_t)row * 10;
    const float rs = rsqrtf((sq[0] + sq[1] + sq[2] + sq[3] + sq[4] + sq[5]) * (1.f / 384.f) + EPS) * qscale;
    const int b = row >> 12, s = row & 4095;
    f32x4 v[4];
#pragma unroll
    for (int nn = 0; nn < 4; ++nn) v[nn] = acc[mm][nn] * rs;
#pragma unroll
    for (int nn = 0; nn < 4; nn += 2) {
      const int c0 = n * 128 + wc * 64 + nn * 16;
      const int d0 = c0 % 96;
      if (d0 == 64) {
        const float* rp = (const float*)(p.ws + OFF_ROPE) + ((size_t)s * 16 + fq * 4) * 2;
        f32x4 a = v[nn], bq = v[nn + 1];
#pragma unroll
        for (int j = 0; j < 4; ++j) { const float cs = rp[2 * j], sn = rp[2 * j + 1]; v[nn][j] = a[j] * cs - bq[j] * sn; v[nn + 1][j] = bq[j] * cs + a[j] * sn; }
      }
    }
#pragma unroll
    for (int nn = 0; nn < 4; ++nn) {
      const int c = n * 128 + wc * 64 + nn * 16 + fq * 4;
      const int hh = c / 96, d = c - hh * 96;
      *(u32x2*)(Q + ((size_t)(b * NH + hh) * S + s) * QKD + d) = (u32x2){pk2(v[nn][0], v[nn][1]), pk2(v[nn][2], v[nn][3])};
    }
  }
}

DI void phase25(const P& p, char* lds, int tid) {
  constexpr int NC = TT / 64, NKV = 136 * 8, NQ = 128 * 6;
  for (int it = blockIdx.x; it < NC + NKV + NQ; it += gridDim.x) {
    if (it < NC) conv_chunks(p, it, tid);
    else if (it < NC + NKV) { int m, n; tile_mn(it - NC, 136, 8, m, n); kv_tile(p, m, n, lds, tid); }
    else { int m, n; tile_mn(it - NC - NKV, 128, 6, m, n); q_tile(p, m, n, lds, tid); }
  }
}
DI void phase3(const P& p, char* lds, int tid) {
  for (int it = blockIdx.x; it < 136 * 40; it += gridDim.x) { int m, n; tile_mn(it, 136, 40, m, n); gates_tile<1>(p, m, n, lds, tid); }
}

DI int swap23(int i) { return (i & 0x13) | ((i & 4) << 1) | ((i & 8) >> 1); }

DI void attn_soft(f32x16& S0, f32x16& O0, f32x16& O1, float& mrun, float& lrun, bool first) {
  float mx = fmaxf(fmaxf(S0[0], S0[1]), S0[2]);
#pragma unroll
  for (int i = 3; i < 15; i += 2) mx = fmaxf(fmaxf(mx, S0[i]), S0[i + 1]);
  mx = fmaxf(mx, S0[15]);
  if (first || __any(mx > 8.0f)) {
    mx = fmaxf(mx, __shfl_xor(mx, 32));
    const float delta = first ? mx : fmaxf(mx, 0.f);
    const float alpha = __builtin_amdgcn_exp2f(-delta);
    mrun += delta; lrun *= alpha;
#pragma unroll
    for (int i = 0; i < 16; ++i) { O0[i] *= alpha; O1[i] *= alpha; S0[i] -= delta; }
  }
  float rsum = 0.f;
#pragma unroll
  for (int i = 0; i < 16; ++i) { S0[i] = __builtin_amdgcn_exp2f(S0[i]); rsum += S0[i]; }
  lrun += rsum;
}
DI void attn_sub2(const char* stg, int kfo, int vfo, int sub, const bf16x8 (&qfa)[6], const bf16x8 (&qfb)[6],
                  f32x16& O0a, f32x16& O1a, f32x16& O0b, f32x16& O1b, float& mruna, float& lruna, float& mrunb, float& lrunb, bool first) {
  f32x16 Sa, Sb;
  { const float na = -mruna, nb = -mrunb;
#pragma unroll
    for (int i = 0; i < 16; ++i) { Sa[i] = na; Sb[i] = nb; } }
#pragma unroll
  for (int s = 0; s < 6; ++s) {
    const bf16x8 kf = *(const bf16x8*)(stg + kfo + sub * (32 * 208) + s * 32);
    Sa = __builtin_amdgcn_mfma_f32_32x32x16_bf16(kf, qfa[s], Sa, 0, 0, 0);
    Sb = __builtin_amdgcn_mfma_f32_32x32x16_bf16(kf, qfb[s], Sb, 0, 0, 0);
  }
  attn_soft(Sa, O0a, O1a, mruna, lruna, first);
  attn_soft(Sb, O0b, O1b, mrunb, lrunb, first);
#pragma unroll
  for (int s = 0; s < 2; ++s) {
    const u32x4 pa = (u32x4){pk2(Sa[8 * s], Sa[8 * s + 1]), pk2(Sa[8 * s + 2], Sa[8 * s + 3]), pk2(Sa[8 * s + 4], Sa[8 * s + 5]), pk2(Sa[8 * s + 6], Sa[8 * s + 7])};
    const u32x4 pb = (u32x4){pk2(Sb[8 * s], Sb[8 * s + 1]), pk2(Sb[8 * s + 2], Sb[8 * s + 3]), pk2(Sb[8 * s + 4], Sb[8 * s + 5]), pk2(Sb[8 * s + 6], Sb[8 * s + 7])};
    const bf16x8 pfa = __builtin_bit_cast(bf16x8, pa), pfb = __builtin_bit_cast(bf16x8, pb);
    const bf16x8 v0f = *(const bf16x8*)(stg + vfo + sub * 64 + s * 32);
    const bf16x8 v1f = *(const bf16x8*)(stg + vfo + 32 * 144 + sub * 64 + s * 32);
    O0a = __builtin_amdgcn_mfma_f32_32x32x16_bf16(v0f, pfa, O0a, 0, 0, 0);
    O1a = __builtin_amdgcn_mfma_f32_32x32x16_bf16(v1f, pfa, O1a, 0, 0, 0);
    O0b = __builtin_amdgcn_mfma_f32_32x32x16_bf16(v0f, pfb, O0b, 0, 0, 0);
    O1b = __builtin_amdgcn_mfma_f32_32x32x16_bf16(v1f, pfb, O1b, 0, 0, 0);
  }
}
DI void attn_store(bf16_t* op, int hh, const f32x16& O0, const f32x16& O1, float lrun) {
  lrun += __shfl_xor(lrun, 32);
  const float il = 1.f / lrun;
#pragma unroll
  for (int g = 0; g < 4; ++g) {
    *(u32x2*)(op + 8 * g + 4 * hh) = (u32x2){pk2(O0[4 * g] * il, O0[4 * g + 1] * il), pk2(O0[4 * g + 2] * il, O0[4 * g + 3] * il)};
    *(u32x2*)(op + 32 + 8 * g + 4 * hh) = (u32x2){pk2(O1[4 * g] * il, O1[4 * g + 1] * il), pk2(O1[4 * g + 2] * il, O1[4 * g + 3] * il)};
  }
}
DI void attn_item(const P& p, int b, int h, int qb, char* lds, int tid) {
  const int lane = tid & 63, wid = tid >> 6, r = lane & 31, hh = lane >> 5;
  bf16_t* Qit = (bf16_t*)(p.ws + OFF_Q) + ((size_t)(b * NH + h) * S + qb * 256) * QKD;
  const bf16_t* Kg = (const bf16_t*)(p.ws + OFF_KB) + (size_t)(b * NH + h) * NKEY * QKD;
  const bf16_t* Vg = (const bf16_t*)(p.ws + OFF_VT) + (size_t)(b * NH + h) * VD * NKEY;
  bf16x8 qfa[6], qfb[6];
#pragma unroll
  for (int s = 0; s < 6; ++s) {
    qfa[s] = *(const bf16x8*)(Qit + (size_t)(wid * 64 + r) * QKD + 16 * s + 8 * hh);
    qfb[s] = *(const bf16x8*)(Qit + (size_t)(wid * 64 + 32 + r) * QKD + 16 * s + 8 * hh);
  }
  f32x16 O0a, O1a, O0b, O1b;
#pragma unroll
  for (int i = 0; i < 16; ++i) { O0a[i] = 0.f; O1a[i] = 0.f; O0b[i] = 0.f; O1b[i] = 0.f; }
  float mruna = 0.f, lruna = 0.f, mrunb = 0.f, lrunb = 0.f;
  constexpr int KSTG = 64 * 208 + 64 * 144;
  const int kq0 = tid, kq1 = tid + 256, kq2 = tid + 512;
  const int kr0 = kq0 / 12, kc0 = kq0 % 12, kr1 = kq1 / 12, kc1 = kq1 % 12, kr2 = kq2 / 12, kc2 = kq2 % 12;
  const int vd0 = tid >> 3, vc0 = tid & 7;
  u32x4 pk0, pk1_, pk2_, pv0, pv1;
  const __amdgpu_buffer_rsrc_t rsk = make_rsrc(Kg), rsv = make_rsrc(Vg);
  const int vok0 = (kr0 * QKD + kc0 * 8) * 2, vok1 = (kr1 * QKD + kc1 * 8) * 2, vok2 = (kr2 * QKD + kc2 * 8) * 2;
  const int vov0 = (vd0 * NKEY + vc0 * 8) * 2, vov1 = ((vd0 + 32) * NKEY + vc0 * 8) * 2;
  {
    pk0 = BLD128(rsk, vok0, 0); pk1_ = BLD128(rsk, vok1, 0); pk2_ = BLD128(rsk, vok2, 0);
    pv0 = BLD128(rsv, vov0, 0); pv1 = BLD128(rsv, vov1, 0);
    *(u32x4*)(lds + kr0 * 208 + kc0 * 16) = pk0; *(u32x4*)(lds + kr1 * 208 + kc1 * 16) = pk1_; *(u32x4*)(lds + kr2 * 208 + kc2 * 16) = pk2_;
    *(u32x4*)(lds + 13312 + vd0 * 144 + vc0 * 16) = pv0; *(u32x4*)(lds + 13312 + (vd0 + 32) * 144 + vc0 * 16) = pv1;
  }
  __syncthreads();
  const int krow = swap23(r);
  const int kfo = krow * 208 + 16 * hh;
  const int vfo = 13312 + r * 144 + 16 * hh;
  constexpr int NTILE = NKEY / 64;
  for (int t = 0; t < NTILE; ++t) {
    const int cur = (t & 1) * KSTG;
    const bool more = (t + 1 < NTILE);
    if (more) {
      const int sk = (t + 1) * (64 * QKD * 2), sv = (t + 1) * 128;
      pk0 = BLD128(rsk, vok0, sk); pk1_ = BLD128(rsk, vok1, sk); pk2_ = BLD128(rsk, vok2, sk);
      pv0 = BLD128(rsv, vov0, sv); pv1 = BLD128(rsv, vov1, sv);
    }
    attn_sub2(lds + cur, kfo, vfo, 0, qfa, qfb, O0a, O1a, O0b, O1b, mruna, lruna, mrunb, lrunb, t == 0);
    __builtin_amdgcn_sched_barrier(0);
    attn_sub2(lds + cur, kfo, vfo, 1, qfa, qfb, O0a, O1a, O0b, O1b, mruna, lruna, mrunb, lrunb, false);
    if (more) {
      const int nxt = (cur == 0) ? KSTG : 0;
      *(u32x4*)(lds + nxt + kr0 * 208 + kc0 * 16) = pk0; *(u32x4*)(lds + nxt + kr1 * 208 + kc1 * 16) = pk1_; *(u32x4*)(lds + nxt + kr2 * 208 + kc2 * 16) = pk2_;
      *(u32x4*)(lds + nxt + 13312 + vd0 * 144 + vc0 * 16) = pv0; *(u32x4*)(lds + nxt + 13312 + (vd0 + 32) * 144 + vc0 * 16) = pv1;
    }
    __syncthreads();
  }
  attn_store(Qit + (size_t)(wid * 64 + r) * 64, hh, O0a, O1a, lruna);
  attn_store(Qit + (size_t)(wid * 64 + 32 + r) * 64, hh, O0b, O1b, lrunb);
}

DI void carry_item(const P& p, int it, int tid) {
  const int b = it / 10, dir = (it / 5) & 1, ch = (it % 5) * 256 + tid;
  const float* sp = (const float*)(p.ws + OFF_SUM) + ((size_t)dir * 136 * LW + ch) * 2;
  float* cp = (float*)(p.ws + OFF_CAR) + (size_t)dir * 128 * LW + ch;
  float cs[34], hs[34];
#pragma unroll
  for (int i = 0; i < 34; ++i) {
    int tile;
    if (dir == 0) tile = i < 2 ? 128 + 2 * b + i : b * 32 + (i - 2);
    else tile = i < 2 ? 129 + 2 * b - i : b * 32 + 31 - (i - 2);
    cs[i] = sp[(size_t)tile * LW * 2]; hs[i] = sp[(size_t)tile * LW * 2 + 1];
  }
  float cy = 0.f;
#pragma unroll
  for (int i = 0; i < 34; ++i) {
    if (i >= 2) { const int j = dir == 0 ? (i - 2) : 31 - (i - 2); cp[(size_t)(b * 32 + j) * LW] = cy; }
    cy = hs[i] + cs[i] * cy;
  }
}
DI void phase4(const P& p, char* lds, int tid0) {
  constexpr int NC = 40, NA = 512, NG = 128 * 40;
  unsigned* flag = (unsigned*)(p.ws + OFF_BAR) + CAR_FLAG_WORD;
  { int tid = tid0; asm volatile("" : "+v"(tid));
    for (int it = blockIdx.x; it < NC; it += gridDim.x) {
      carry_item(p, it, tid);
      asm volatile("s_waitcnt vmcnt(0)" ::: "memory");
      __syncthreads();
      if (tid == 0) { __builtin_amdgcn_fence(__ATOMIC_RELEASE, "agent"); asm volatile("s_waitcnt vmcnt(0)" ::: "memory"); (void)xb_add(flag, 1u); }
    } }
  { int tid = tid0; asm volatile("" : "+v"(tid));
    for (int ia = blockIdx.x; ia < NA; ia += gridDim.x) {
      int pair, qb;
      if (gridDim.x == 512) { const int xcd = ia & 7, slot = ia >> 3; pair = xcd * 4 + (slot >> 4); qb = slot & 15; }
      else { pair = ia >> 4; qb = ia & 15; }
      attn_item(p, pair >> 3, pair & 7, qb, lds, tid);
    } }
  { int tid = tid0; asm volatile("" : "+v"(tid));
    if (tid == 0) {
      unsigned sp_ = 0; while (xb_ld(flag) < (unsigned)NC) { __builtin_amdgcn_s_sleep(2); if (++sp_ > (1u << 22)) break; }
      __builtin_amdgcn_fence(__ATOMIC_ACQUIRE, "agent"); asm volatile("s_waitcnt vmcnt(0)" ::: "memory");
    }
    __syncthreads();
    for (int it = blockIdx.x; it < NG; it += gridDim.x) { int m, n; tile_mn(it, 128, 40, m, n); gates_tile<2>(p, m, n, lds, tid); }
  }
}

struct LoadAT {
  const bf16_t* Q; int m0;
  DI const void* base() const { return Q; }
  DI int voff(int row, int k) const {
    const int t = m0 + row;
    return ((((t >> 12) * NH) * S + (t & 4095 & ~255)) * QKD + (t & 255) * 64 + k) * 2;
  }
  DI int kstep() const { return S * QKD * 2; }
};
#ifndef P5PIPE
#define P5PIPE false
#endif
DI void phase5(const P& p, char* lds, int tid) {
  const int lane = tid & 63, wid = tid >> 6, wr = wid >> 1, wc = wid & 1, fr = lane & 15, fq = lane >> 4;
  const bf16_t* H1 = (const bf16_t*)(p.ws + OFF_H1);
  const bf16_t* WG = (const bf16_t*)(p.ws + OFF_WG);
  bf16_t* M1 = (bf16_t*)(p.ws + OFF_M1);
#pragma unroll 1
  for (int job = 0; job < 2; ++job) {
#pragma unroll 1
    for (int t = blockIdx.x; t < 128 * 8; t += gridDim.x) {
      int m, n; tile_mn(t, 128, 8, m, n);
      bf16_t* GT = (bf16_t*)(p.ws + OFF_Z) + ZC_XB;
      {
        f32x4 acc[4][4]; zero_acc(acc);
        LoadPlain lh{H1 + (size_t)m * 128 * 1024, 1024};
        gemm_k<true>(acc, lh, WG + (size_t)(job * 1024 + n * 128) * 1024, 1024, 1024, lds, tid);
#pragma unroll
        for (int nn = 0; nn < 4; ++nn) {
          const int col = n * 128 + wc * 64 + nn * 16 + fq * 4;
          const f32x4 bg = *(const f32x4*)(p.b_gate + job * 1024 + col);
#pragma unroll
          for (int mm = 0; mm < 4; ++mm) {
            const int row = m * 128 + wr * 64 + mm * 16 + fr;
            *(u32x2*)(GT + (size_t)row * ZLD + col) = (u32x2){pk2(sigm(acc[mm][nn][0] + bg[0]), sigm(acc[mm][nn][1] + bg[1])), pk2(sigm(acc[mm][nn][2] + bg[2]), sigm(acc[mm][nn][3] + bg[3]))};
          }
        }
      }
      f32x4 keep[4][4]; zero_acc(keep);
      if (job == 0) { LoadAT la{(const bf16_t*)(p.ws + OFF_Q), m * 128}; gemm_k<P5PIPE>(keep, la, (const bf16_t*)(p.ws + OFF_WOA) + (size_t)n * 128 * 512, 512, 512, lds, tid); }
      else { LoadPlain la{(const bf16_t*)(p.ws + OFF_Z) + (size_t)m * 128 * ZLD + ZC_YB, ZLD}; gemm_k<P5PIPE>(keep, la, (const bf16_t*)(p.ws + OFF_WOL) + (size_t)n * 128 * LW, LW, LW, lds, tid); }
#pragma unroll
      for (int nn = 0; nn < 4; ++nn) {
        const int col = n * 128 + wc * 64 + nn * 16 + fq * 4;
#pragma unroll
        for (int mm = 0; mm < 4; ++mm) {
          const int row = m * 128 + wr * 64 + mm * 16 + fr;
          const u32x2 g = *(const u32x2*)(GT + (size_t)row * ZLD + col);
          f32x4 v;
          v[0] = bflo(g[0]) * keep[mm][nn][0]; v[1] = bfhi(g[0]) * keep[mm][nn][1];
          v[2] = bflo(g[1]) * keep[mm][nn][2]; v[3] = bfhi(g[1]) * keep[mm][nn][3];
          bf16_t* mp = M1 + (size_t)row * 1024 + col;
          if (job == 1) { const u32x2 pr = *(const u32x2*)mp; v[0] += bflo(pr[0]); v[1] += bfhi(pr[0]); v[2] += bflo(pr[1]); v[3] += bfhi(pr[1]); }
          *(u32x2*)mp = (u32x2){pk2(v[0], v[1]), pk2(v[2], v[3])};
        }
      }
    }
  }
}

DI void resid_epilogue(const P& p, f32x4 (&acc)[4][4], const float* __restrict__ base, int modoff, int m, int n, int tid) {
  const int lane = tid & 63, wid = tid >> 6, wr = wid >> 1, wc = wid & 1, fr = lane & 15, fq = lane >> 4;
  const float* MOD = (const float*)(p.ws + OFF_MOD);
  float* SSQ = (float*)(p.ws + OFF_SSQ2);
#pragma unroll
  for (int mm = 0; mm < 4; ++mm) {
    const int row = m * 128 + wr * 64 + mm * 16 + fr, b = row >> 12;
    float ss = 0.f;
#pragma unroll
    for (int nn = 0; nn < 4; ++nn) {
      const int col = n * 128 + wc * 64 + nn * 16 + fq * 4;
      const f32x4 g = *(const f32x4*)(MOD + (size_t)b * 6144 + modoff + col);
      const f32x4 xv = *(const f32x4*)(base + (size_t)row * 1024 + col);
      const f32x4 v = xv + g * acc[mm][nn];
      *(f32x4*)(p.out + (size_t)row * 1024 + col) = v;
      ss += v[0] * v[0] + v[1] * v[1] + v[2] * v[2] + v[3] * v[3];
    }
    ss += __shfl_xor(ss, 16); ss += __shfl_xor(ss, 32);
    if (fq == 0) SSQ[(size_t)row * 16 + n * 2 + wc] = ss;
  }
}
DI void phase6(const P& p, char* lds, int tid) {
  for (int t = blockIdx.x; t < 128 * 8; t += gridDim.x) {
    int m, n; tile_mn(t, 128, 8, m, n);
    f32x4 acc[4][4]; zero_acc(acc);
    LoadPlain la{(const bf16_t*)(p.ws + OFF_M1) + (size_t)m * 128 * 1024, 1024};
    gemm_k<true>(acc, la, (const bf16_t*)(p.ws + OFF_WOUT) + (size_t)n * 128 * 1024, 1024, 1024, lds, tid);
    resid_epilogue(p, acc, p.x, 2048, m, n, tid);
  }
}
DI void phase8(const P& p, char* lds, int tid) {
  for (int t = blockIdx.x; t < 128 * 8; t += gridDim.x) {
    int m, n; tile_mn(t, 128, 8, m, n);
    f32x4 acc[4][4]; zero_acc(acc);
    LoadPlain la{(const bf16_t*)(p.ws + OFF_FF) + (size_t)m * 128 * FFN, FFN};
    gemm_k<true>(acc, la, (const bf16_t*)(p.ws + OFF_WD) + (size_t)n * 128 * FFN, FFN, FFN, lds, tid);
    resid_epilogue(p, acc, p.out, 5120, m, n, tid);
  }
}

DI void phase7(const P& p, char* lds, int tid) {
  const int lane = tid & 63, wid = tid >> 6, wr = wid >> 1, wc = wid & 1, fr = lane & 15, fq = lane >> 4;
  bf16_t* FF = (bf16_t*)(p.ws + OFF_FF);
  constexpr int MT = 131, NT = 44;
  for (int t = blockIdx.x; t < tile_rect_count(MT, NT); t += gridDim.x) {
    int m, n; if (!tile_rect(t, MT, NT, m, n)) continue;
    const int m0 = m * 126 - 1;
    f32x4 acc[4][4]; zero_acc(acc);
    LoadClamp la{(const bf16_t*)(p.ws + OFF_H1), 1024, m0};
    gemm_k<true>(acc, la, (const bf16_t*)(p.ws + OFF_WUP) + (size_t)n * 128 * 1024, 1024, 1024, lds, tid);
    float* AL = (float*)lds;
#pragma unroll
    for (int mm = 0; mm < 4; ++mm)
#pragma unroll
      for (int nn = 0; nn < 2; ++nn) *(f32x4*)(AL + (wr * 64 + mm * 16 + fr) * 64 + wc * 32 + nn * 16 + fq * 4) = acc[mm][nn];
    __syncthreads();
#pragma unroll
    for (int nn = 0; nn < 2; ++nn) {
      const int chl = wc * 32 + nn * 16 + fq * 4, ch = n * 64 + chl;
      const f32x4 w0 = *(const f32x4*)(p.ffn_conv_w + ch), w1 = *(const f32x4*)(p.ffn_conv_w + FFN + ch), w2 = *(const f32x4*)(p.ffn_conv_w + 2 * FFN + ch);
      const f32x4 cbv = *(const f32x4*)(p.ffn_conv_b + ch);
#pragma unroll
      for (int mm = 0; mm < 4; ++mm) {
        const int rl = wr * 64 + mm * 16 + fr, g = m0 + rl;
        if (rl >= 1 && rl <= 126 && g < TL) {
          const int s = g & 4095;
          f32x4 cv = cbv + w1 * acc[mm][nn];
          if (s > 0) cv += w0 * *(const f32x4*)(AL + (rl - 1) * 64 + chl);
          if (s < S - 1) cv += w2 * *(const f32x4*)(AL + (rl + 1) * 64 + chl);
          f32x4 o;
#pragma unroll
          for (int j = 0; j < 4; ++j) o[j] = cv[j] * sigm(cv[j]) * acc[mm][nn + 2][j];
          *(u32x2*)(FF + (size_t)g * FFN + ch) = (u32x2){pk2(o[0], o[1]), pk2(o[2], o[3])};
        }
      }
    }
    __syncthreads();
  }
}

DI void phase65(const P& p, int tid) {
  const int lane = tid & 63, wid = tid >> 6;
  const float* SSQ = (const float*)(p.ws + OFF_SSQ2);
  const float* GS2 = (const float*)(p.ws + OFF_GS2);
  const float* MOD = (const float*)(p.ws + OFF_MOD);
  bf16_t* H2 = (bf16_t*)(p.ws + OFF_H1);
  for (int it = blockIdx.x; it < TL / 16; it += gridDim.x) {
#pragma unroll
    for (int tt = 0; tt < 4; ++tt) {
      const int row = it * 16 + wid * 4 + tt, b = row >> 12;
      float s = (lane < 16) ? SSQ[(size_t)row * 16 + lane] : 0.f;
      s = wave_sum(s);
      const float rs = rsqrtf(s * (1.f / 1024.f) + EPS);
      const float* xp = p.out + (size_t)row * 1024;
#pragma unroll
      for (int i = 0; i < 4; ++i) {
        const int k = i * 256 + lane * 4;
        const f32x4 v = *(const f32x4*)(xp + k), g = *(const f32x4*)(GS2 + b * 1024 + k), sh = *(const f32x4*)(MOD + (size_t)b * 6144 + 3072 + k);
        const f32x4 y = v * rs * g + sh;
        *(u32x2*)(H2 + (size_t)row * 1024 + k) = (u32x2){pk2(y[0], y[1]), pk2(y[2], y[3])};
      }
    }
  }
}

DI void phase9(const P& p, int tid) {
  const int lane = tid & 63, wid = tid >> 6;
  const float* SSQ = (const float*)(p.ws + OFF_SSQ2);
  for (int it = blockIdx.x; it < TL / 16; it += gridDim.x) {
    for (int tt = 0; tt < 4; ++tt) {
      const int row = it * 16 + wid * 4 + tt;
      float s = (lane < 16) ? SSQ[(size_t)row * 16 + lane] : 0.f;
      s = wave_sum(s);
      const float rs = rsqrtf(s * (1.f / 1024.f) + EPS);
      float* op = p.out + (size_t)row * 1024;
#pragma unroll
      for (int i = 0; i < 4; ++i) {
        const int k = i * 256 + lane * 4;
        const f32x4 v = *(const f32x4*)(op + k), g = *(const f32x4*)(p.final_g + k);
        *(f32x4*)(op + k) = v * rs * g;
      }
    }
  }
}


#ifndef PH_MASK
#define PH_MASK 0x3ff
#endif
#ifndef REP_MASK
#define REP_MASK 0
#endif
__global__ void __launch_bounds__(256, 2) fwd_megakernel(P p) {
  __shared__ __attribute__((aligned(16))) char lds[LDS_BYTES];
  cg::grid_group grid = cg::this_grid();
  if (p.ws == nullptr) grid.sync();
  volatile LAS unsigned* st = (volatile LAS unsigned*)(LAS char*)(lds + LDS_X + 4080);
  if (threadIdx.x == 0) { st[0] = 0u; st[1] = 0u; }
  __syncthreads();
  const XcdBarrier xb = xcd_barrier_post((unsigned*)(p.ws + OFF_BAR), st);
#define PHASE_TID int tid = threadIdx.x; asm volatile("" : "+v"(tid));
#define GRID_SYNC xcd_barrier(xb)
  if (PH_MASK & (1 << 0)) { PHASE_TID phase0(p, lds, tid); }
  if (REP_MASK & (1 << 0)) { GRID_SYNC; PHASE_TID phase0(p, lds, tid); }
  GRID_SYNC;
  if (PH_MASK & (1 << 1)) { PHASE_TID phase1(p, lds, tid); }
  if (REP_MASK & (1 << 1)) { GRID_SYNC; PHASE_TID phase1(p, lds, tid); }
  GRID_SYNC;
  if (PH_MASK & (1 << 2)) { PHASE_TID phase2(p, lds, tid); }
  if (REP_MASK & (1 << 2)) { GRID_SYNC; PHASE_TID phase2(p, lds, tid); }
  GRID_SYNC;
  { PHASE_TID phase25(p, lds, tid); }
  GRID_SYNC;
  if (PH_MASK & (1 << 3)) { PHASE_TID phase3(p, lds, tid); }
  if (REP_MASK & (1 << 3)) { GRID_SYNC; PHASE_TID phase3(p, lds, tid); }
  GRID_SYNC;
  if (PH_MASK & (1 << 4)) { PHASE_TID phase4(p, lds, tid); }
  GRID_SYNC;
  if (PH_MASK & (1 << 5)) { PHASE_TID phase5(p, lds, tid); }
  if (REP_MASK & (1 << 5)) { GRID_SYNC; PHASE_TID phase5(p, lds, tid); }
  GRID_SYNC;
  if (PH_MASK & (1 << 6)) { PHASE_TID phase6(p, lds, tid); }
  if (REP_MASK & (1 << 6)) { GRID_SYNC; PHASE_TID phase6(p, lds, tid); }
  GRID_SYNC;
  { PHASE_TID phase65(p, tid); }
  GRID_SYNC;
  if (PH_MASK & (1 << 7)) { PHASE_TID phase7(p, lds, tid); }
  if (REP_MASK & (1 << 7)) { GRID_SYNC; PHASE_TID phase7(p, lds, tid); }
  GRID_SYNC;
  if (PH_MASK & (1 << 8)) { PHASE_TID phase8(p, lds, tid); }
  GRID_SYNC;
  if (PH_MASK & (1 << 9)) { PHASE_TID phase9(p, tid); }
}

extern "C" void kernel_launch(void* const* d_in, const int* in_sizes, int n_in, void* d_out, int out_size, void* d_ws, size_t ws_size,
                              hipStream_t stream) {
  static int grid_blocks = 0;
  if (!grid_blocks) {
    int dev = 0, cus = 0, per_cu = 0;
    (void)hipGetDevice(&dev);
    (void)hipDeviceGetAttribute(&cus, hipDeviceAttributeMultiprocessorCount, dev);
    (void)hipOccupancyMaxActiveBlocksPerMultiprocessor(&per_cu, fwd_megakernel, 256, 0);
    if (per_cu > 2) per_cu = 2;
    if (per_cu < 1) per_cu = 1;
    grid_blocks = cus * per_cu;
  }
  if (ws_size < WS_END + BAR_BYTES + HALO_BYTES + CAR_BYTES) fprintf(stderr, "workspace too small: %zu < %zu\n", ws_size, (size_t)WS_END);
  P p{};
  const float** f = (const float**)&p;
  for (int i = 0; i < 29; ++i) f[i] = (const float*)d_in[i];
  p.out = (float*)d_out;
  p.ws = (char*)d_ws;
  (void)hipMemsetAsync((char*)d_ws + OFF_BAR, 0, BAR_BYTES, stream);
  void* args[] = {&p};
  hipError_t e = hipLaunchCooperativeKernel((void*)fwd_megakernel, dim3(grid_blocks), dim3(256), args, 0, stream);
  if (e != hipSuccess) fprintf(stderr, "cooperative launch failed: %s (grid %d)\n", hipGetErrorString(e), grid_blocks);
}
```

```cpp
#include <hip/hip_runtime.h>
#include <hip/hip_cooperative_groups.h>
#include <cstdio>
#include <cstdint>
namespace cg = cooperative_groups;

typedef unsigned short bf16_t;
typedef short bf16x8 __attribute__((ext_vector_type(8)));
typedef float f32x4 __attribute__((ext_vector_type(4)));
typedef float f32x16 __attribute__((ext_vector_type(16)));
typedef unsigned u32x4 __attribute__((ext_vector_type(4)));
typedef unsigned u32x2 __attribute__((ext_vector_type(2)));
#define DI __device__ __forceinline__

constexpr int D = 1024, NB = 4, S = 4096, CL = 256;
constexpr int TL = NB * S;
constexpr int TC = NB * CL;
constexpr int TT = TL + TC;
constexpr int NKEY = S + CL;
constexpr int NH = 8, QKD = 96, VD = 64;
constexpr int LW = 1280;
constexpr int FFN = 2816;
constexpr int IN_DIM = 5280;
constexpr float EPS = 1e-6f;
constexpr int ZLD = 3328;
constexpr int ZC_QL = 0, ZC_KVL = 384, ZC_XB = 640, ZC_YB = 1920, ZC_KR = 3200;
constexpr int NT_Z = ZLD / 128;

constexpr size_t OFF_WIN = 0;
constexpr size_t OFF_WG = OFF_WIN + (size_t)ZLD * 1024 * 2;
constexpr size_t OFF_WUQ = OFF_WG + (size_t)2048 * 1024 * 2;
constexpr size_t OFF_WUKV = OFF_WUQ + (size_t)768 * 384 * 2;
constexpr size_t OFF_WOA = OFF_WUKV + (size_t)1024 * 256 * 2;
constexpr size_t OFF_GATES = OFF_WOA + (size_t)1024 * 512 * 2;
constexpr size_t OFF_WOL = OFF_GATES + (size_t)40 * 128 * 128 * 2;
constexpr size_t OFF_WOUT = OFF_WOL + (size_t)1024 * 1280 * 2;
constexpr size_t OFF_WUP = OFF_WOUT + (size_t)1024 * 1024 * 2;
constexpr size_t OFF_WD = OFF_WUP + (size_t)5632 * 1024 * 2;
constexpr size_t OFF_SP = OFF_WD + (size_t)1024 * 2816 * 2;
constexpr size_t OFF_ROPE = OFF_SP + 2 * 1280 * 4;
constexpr size_t OFF_MODP = OFF_ROPE + (size_t)4096 * 16 * 2 * 4;
constexpr size_t OFF_MOD = OFF_MODP + (size_t)8 * 5 * 6144 * 4;
constexpr size_t OFF_GS2 = OFF_MOD + (size_t)5 * 6144 * 4;
constexpr size_t OFF_SSQ1 = OFF_GS2 + 4 * 1024 * 4;
constexpr size_t OFF_SUM = OFF_SSQ1 + (size_t)TT * 10 * 4;
constexpr size_t OFF_SSQ2 = OFF_SUM + (size_t)2 * 136 * 1280 * 2 * 4;
constexpr size_t OFF_H1 = OFF_SSQ2 + (size_t)TL * 16 * 4;
constexpr size_t OFF_Z = OFF_H1 + (size_t)TT * 1024 * 2;
constexpr size_t OFF_Q = OFF_Z + (size_t)TT * ZLD * 2;
constexpr size_t OFF_KB = OFF_Q + (size_t)NB * NH * S * QKD * 2;
constexpr size_t OFF_VT = OFF_KB + (size_t)NB * NH * NKEY * QKD * 2;
constexpr size_t WS_END = OFF_VT + (size_t)NB * NH * VD * NKEY * 2;
constexpr size_t OFF_BAR = WS_END;
constexpr size_t BAR_BYTES = 16384;
constexpr size_t OFF_HALO = OFF_BAR + BAR_BYTES;
constexpr size_t HALO_BYTES = (size_t)272 * 3 * 1280 * 2;
constexpr size_t OFF_CAR = OFF_HALO + HALO_BYTES;
constexpr size_t CAR_BYTES = (size_t)2 * 128 * 1280 * 4;
constexpr int CAR_FLAG_WORD = 3600;
constexpr size_t OFF_M1 = OFF_KB;
constexpr size_t OFF_FF = OFF_Z;
static_assert(WS_END + BAR_BYTES + HALO_BYTES + CAR_BYTES <= (size_t)256 * 1024 * 1024, "workspace too large");
static_assert((size_t)TL * 1024 * 2 <= WS_END - OFF_KB, "M1 overlay");
static_assert((size_t)TL * FFN * 2 <= (size_t)TT * ZLD * 2, "FF overlay");

constexpr int LDS_BYTES = 65536 + 4096;
constexpr int LDS_X = 65536;

struct P {
  const float *x, *c, *ctx, *c_ctx, *w_mod, *b_mod, *norm1_g, *w_in, *b_gate, *q_norm_g, *kv_norm_g, *w_uq, *w_ukv, *w_o_attn,
      *lru_conv_w, *lru_conv_b, *lru_w_a, *lru_b_a, *lru_w_x, *lru_b_x, *lru_lambda, *w_o_lru, *w_out, *norm2_g, *w_up,
      *ffn_conv_w, *ffn_conv_b, *w_down, *final_g;
  float* out;
  char* ws;
};

typedef __bf16 bf16x2_t __attribute__((ext_vector_type(2)));
typedef float f32x2_t __attribute__((ext_vector_type(2)));
DI unsigned pk2(float lo, float hi) { const f32x2_t v = {lo, hi}; return __builtin_bit_cast(unsigned, __builtin_convertvector(v, bf16x2_t)); }
DI float bflo(unsigned u) { return __uint_as_float(u << 16); }
DI float bfhi(unsigned u) { return __uint_as_float(u & 0xffff0000u); }
DI float sigm(float x) { return __builtin_amdgcn_rcpf(1.f + __expf(-x)); }
DI float gelu_tanh(float x) { float z = 0.7978845608f * (x + 0.044715f * x * x * x); float e = __expf(2.f * z); float t = 1.f - 2.f * __builtin_amdgcn_rcpf(e + 1.f); return 0.5f * x * (1.f + t); }
DI float wave_sum(float v) {
  v += __shfl_xor(v, 32); v += __shfl_xor(v, 16); v += __shfl_xor(v, 8); v += __shfl_xor(v, 4); v += __shfl_xor(v, 2); v += __shfl_xor(v, 1); return v;
}
DI void tile_mn(int t, int MT, int NT, int& m, int& n) {
  const int g = t / (8 * NT); const int rem = t - g * 8 * NT; int gsz = MT - 8 * g; gsz = gsz > 8 ? 8 : gsz;
  m = 8 * g + rem % gsz; n = rem / gsz;
}

DI bool tile_rect(int t, int MT, int NT, int& m, int& n) {
  const int xcd = t & 7, u = t >> 3, rq = u >> 4, wi = u & 15;
  const int q = ((rq >> 2) * 8 + xcd) * 4 + (rq & 3);
  const int hn = NT >> 1, g = q / hn, n2 = q - g * hn;
  m = 8 * g + (wi & 7); n = 2 * n2 + (wi >> 3);
  return m < MT;
}
DI int tile_rect_count(int MT, int NT) { const int qn = ((MT + 7) >> 3) * (NT >> 1); return ((qn + 31) >> 5) * 512; }
#define LAS3 __attribute__((address_space(3)))
#define GAS1 __attribute__((address_space(1)))
DI void glds16(const bf16_t* g, char* l) { __builtin_amdgcn_global_load_lds((const GAS1 void*)g, (LAS3 void*)(LAS3 char*)l, 16, 0, 0); }
DI __amdgpu_buffer_rsrc_t make_rsrc(const void* base) { return __builtin_amdgcn_make_buffer_rsrc((void*)base, 0, 0x7fffffff, 0x00020000); }
DI void bl16(__amdgpu_buffer_rsrc_t r, int voff, int soff, char* l) { __builtin_amdgcn_raw_ptr_buffer_load_lds(r, (LAS3 void*)(LAS3 char*)l, 16, voff, soff, 0, 0); }
#define BLD128(R, VO, SO) __builtin_bit_cast(u32x4, __builtin_amdgcn_raw_buffer_load_b128(R, VO, SO, 0))
#define BL16_4(R, VO, SO, L) do { LAS3 void* l_ = (LAS3 void*)(LAS3 char*)(L); \
    __builtin_amdgcn_raw_ptr_buffer_load_lds(R, l_, 16, (VO)[0], SO, 0, 0);    __builtin_amdgcn_raw_ptr_buffer_load_lds(R, l_, 16, (VO)[1], SO, 1024, 0); \
    __builtin_amdgcn_raw_ptr_buffer_load_lds(R, l_, 16, (VO)[2], SO, 2048, 0); __builtin_amdgcn_raw_ptr_buffer_load_lds(R, l_, 16, (VO)[3], SO, 3072, 0); } while (0)
template <bool PIPE, class AA>
DI void gemm_k(f32x4 (&acc)[4][4], const AA& aa, const bf16_t* __restrict__ Bt, int ldb, int K, char* lds, int tid) {
  const int lane = tid & 63, wid = tid >> 6, wr = wid >> 1, wc = wid & 1, fr = lane & 15, fq = lane >> 4;
  const int row0 = wid * 32 + (lane >> 3);
  const int cl = ((lane & 7) ^ ((lane >> 3) & 7)) * 8;
  const int ldst = wid * 4096 + lane * 16;
  const int nk = K >> 6;
  const __amdgpu_buffer_rsrc_t rsa = make_rsrc((const char*)aa.base() - 4096), rsb = make_rsrc((const char*)Bt - 4096);
  int voa[4], vob[4];
#pragma unroll
  for (int i = 0; i < 4; ++i) { voa[i] = aa.voff(row0 + 8 * i, cl) + 4096 - i * 1024; vob[i] = ((row0 + 8 * i) * ldb + cl) * 2 + 4096 - i * 1024; }
  const int ksa = aa.kstep();
  BL16_4(rsa, voa, 0, lds + ldst);
  BL16_4(rsb, vob, 0, lds + 16384 + ldst);
  const int aoff = (wr * 64 + fr) * 128, boff = 16384 + (wc * 64 + fr) * 128;
  const int x0 = ((0 + fq) ^ (fr & 7)) << 4, x1 = ((4 + fq) ^ (fr & 7)) << 4;
  for (int kt = 0; kt < nk; ++kt) {
    const int cur = (kt & 1) * 32768;
    asm volatile("s_waitcnt vmcnt(0)" ::: "memory");
    __syncthreads();
    if (kt + 1 < nk) {
      const int nxt = cur ^ 32768;
      BL16_4(rsa, voa, (kt + 1) * ksa, lds + nxt + ldst);
      BL16_4(rsb, vob, (kt + 1) * 128, lds + nxt + 16384 + ldst);
    }
    if (PIPE) {
      bf16x8 af[2][4], bfr[2][4];
#pragma unroll
      for (int m = 0; m < 4; ++m) af[0][m] = *(const bf16x8*)(lds + cur + aoff + m * 2048 + x0);
#pragma unroll
      for (int n = 0; n < 4; ++n) bfr[0][n] = *(const bf16x8*)(lds + cur + boff + n * 2048 + x0);
#pragma unroll
      for (int m = 0; m < 4; ++m) af[1][m] = *(const bf16x8*)(lds + cur + aoff + m * 2048 + x1);
#pragma unroll
      for (int n = 0; n < 4; ++n) bfr[1][n] = *(const bf16x8*)(lds + cur + boff + n * 2048 + x1);
#pragma unroll
      for (int kk = 0; kk < 2; ++kk)
#pragma unroll
        for (int m = 0; m < 4; ++m)
#pragma unroll
          for (int n = 0; n < 4; ++n) acc[m][n] = __builtin_amdgcn_mfma_f32_16x16x32_bf16(bfr[kk][n], af[kk][m], acc[m][n], 0, 0, 0);
      __builtin_amdgcn_sched_group_barrier(0x100, 8, 0);
#pragma unroll
      for (int i = 0; i < 8; ++i) { __builtin_amdgcn_sched_group_barrier(0x008, 2, 0); __builtin_amdgcn_sched_group_barrier(0x100, 1, 0); }
      __builtin_amdgcn_sched_group_barrier(0x008, 16, 0);
    } else {
#pragma unroll
      for (int kk = 0; kk < 2; ++kk) {
        const int xo = kk ? x1 : x0;
        bf16x8 af[4], bfr[4];
#pragma unroll
        for (int m = 0; m < 4; ++m) af[m] = *(const bf16x8*)(lds + cur + aoff + m * 2048 + xo);
#pragma unroll
        for (int n = 0; n < 4; ++n) bfr[n] = *(const bf16x8*)(lds + cur + boff + n * 2048 + xo);
#pragma unroll
        for (int m = 0; m < 4; ++m)
#pragma unroll
          for (int n = 0; n < 4; ++n) acc[m][n] = __builtin_amdgcn_mfma_f32_16x16x32_bf16(bfr[n], af[m], acc[m][n], 0, 0, 0);
      }
    }
  }
  __syncthreads();
}
struct LoadPlain {
  const bf16_t* A; int lda;
  DI const void* base() const { return A; }
  DI int voff(int row, int k) const { return (row * lda + k) * 2; }
  DI int kstep() const { return 128; }
};
struct LoadClamp {
  const bf16_t* A; int lda, m0;
  DI const void* base() const { return A; }
  DI int voff(int row, int k) const { int g = m0 + row; g = g < 0 ? 0 : (g > TL - 1 ? TL - 1 : g); return (g * lda + k) * 2; }
  DI int kstep() const { return 128; }
};
DI void zero_acc(f32x4 (&acc)[4][4]) {
#pragma unroll
  for (int m = 0; m < 4; ++m)
#pragma unroll
    for (int n = 0; n < 4; ++n) acc[m][n] = (f32x4){0.f, 0.f, 0.f, 0.f};
}


#define XB_TMO      128
#define XB_XCNT(j)  (256  + 64 * (j))
#define XB_XSUB(j)  (1280 + 64 * (j))
#define XB_XGEN(j)  (2304 + 64 * (j))
#define XB_TOP      3328
#define XB_TOPGEN   3392
#define XCD_BAR_WORDS 3456
#define XB_SPIN_CAP (1u << 18)
#define LAS __attribute__((address_space(3)))
DI unsigned xb_ld(unsigned* p) { return __hip_atomic_load(p, __ATOMIC_RELAXED, __HIP_MEMORY_SCOPE_AGENT); }
DI unsigned xb_add(unsigned* p, unsigned v) { return __hip_atomic_fetch_add(p, v, __ATOMIC_RELAXED, __HIP_MEMORY_SCOPE_AGENT); }
DI unsigned xb_xcc_id() { return (unsigned)__builtin_amdgcn_s_getreg((3 << 11) | 20) & 0xFu; }
#define XB_SPIN(cond, bar) do { unsigned _sp = 0; while (cond) { __builtin_amdgcn_s_sleep(1); \
    if ((++_sp & 255u) == 0u) { if (xb_ld(&(bar)[XB_TMO])) break; if (_sp > XB_SPIN_CAP) { atomicAdd(&(bar)[XB_TMO], 1u); break; } } } } while (0)
struct XcdBarrier { unsigned* bar; unsigned x; volatile LAS unsigned* st; };
DI XcdBarrier xcd_barrier_post(unsigned* bar, volatile LAS unsigned* st) {
  XcdBarrier b; b.bar = bar; b.x = xb_xcc_id(); b.st = st;
  if (threadIdx.x == 0) (void)xb_add(&bar[XB_XCNT(b.x)], 1u);
  return b;
}
DI void xcd_barrier_complete(unsigned* bar, unsigned x, unsigned& nloc, unsigned& nx) {
  const unsigned G = gridDim.x * gridDim.y * gridDim.z;
  unsigned sum, cnt, mine, sp = 0u;
  for (;;) {
    sum = 0u; cnt = 0u; mine = 0u;
#pragma unroll
    for (unsigned j = 0; j < 16; ++j) { const unsigned c = xb_ld(&bar[XB_XCNT(j)]); sum += c; cnt += (c > 0u) ? 1u : 0u; mine = (j == x) ? c : mine; }
    if (sum == G) break;
    __builtin_amdgcn_s_sleep(1);
    if ((++sp & 255u) == 0u) { if (xb_ld(&bar[XB_TMO])) break; if (sp > XB_SPIN_CAP) { atomicAdd(&bar[XB_TMO], 1u); break; } }
  }
  nloc = mine > 0u ? mine : 1u; nx = cnt > 0u ? cnt : 1u;
}
DI void xcd_barrier(const XcdBarrier& b) {
  asm volatile("s_waitcnt vmcnt(0)" ::: "memory");
  __syncthreads();
  if (threadIdx.x == 0) {
    unsigned* bar = b.bar;
    __builtin_amdgcn_s_waitcnt(0);
    unsigned nloc = b.st[0], nx = b.st[1];
    if (nloc == 0u) { xcd_barrier_complete(bar, b.x, nloc, nx); b.st[0] = nloc; b.st[1] = nx; }
    const unsigned old = xb_add(&bar[XB_XSUB(b.x)], 1u);
    const unsigned gen = old / nloc;
    if (old + 1u == (gen + 1u) * nloc) {
      __builtin_amdgcn_fence(__ATOMIC_RELEASE, "agent");
      asm volatile("s_waitcnt vmcnt(0)" ::: "memory");
      const unsigned og = xb_add(&bar[XB_TOP], 1u);
      const unsigned tg = og / nx;
      if (og + 1u == (tg + 1u) * nx) xb_add(&bar[XB_TOPGEN], 1u);
      else XB_SPIN(xb_ld(&bar[XB_TOPGEN]) == tg, bar);
      __builtin_amdgcn_fence(__ATOMIC_ACQUIRE, "agent");
      xb_add(&bar[XB_XGEN(b.x)], 1u);
      asm volatile("s_waitcnt vmcnt(0)" ::: "memory");
    } else {
      XB_SPIN(xb_ld(&bar[XB_XGEN(b.x)]) == gen, bar);
      __builtin_amdgcn_fence(__ATOMIC_ACQUIRE, "agent");
      asm volatile("s_waitcnt vmcnt(0)" ::: "memory");
    }
  }
  __syncthreads();
}

DI int map_row(int mode, int aux, int n) {
  if (mode == 0) return n;
  if (mode == 1) {
    if (n < 640) return n;
    if (n < 672) return ZC_KR + (n - 640);
    if (n < 3232) return n - 32;
    return ZLD + (n - 3232);
  }
  if (mode == 2) {
    const int cb = aux >> 2, sub = aux & 3;
    return (cb * 4 + (n >> 5)) * 128 + ((n >> 4) & 1) * 64 + sub * 16 + (n & 15);
  }
  const int gate = n >= FFN ? 1 : 0, ch = n - gate * FFN;
  return (ch >> 6) * 128 + ((ch >> 5) & 1) * 64 + gate * 32 + (ch & 31);
}
DI void transpose_tile(const float* __restrict__ src, int K, int N, int kt, int nt, bf16_t* __restrict__ dst, int dst_ld, int mode, int aux,
                       const float* __restrict__ kscale, char* lds, int tid) {
  float* T = (float*)lds;
  const int n4 = (tid & 15) * 4, nn = nt * 64 + n4;
#pragma unroll
  for (int i = 0; i < 4; ++i) {
    const int kl = i * 16 + (tid >> 4), k = kt * 64 + kl;
    f32x4 v = (nn < N) ? *(const f32x4*)(src + (size_t)k * N + nn) : (f32x4){0.f, 0.f, 0.f, 0.f};
    if (kscale) v *= kscale[k];
    T[kl * 65 + n4] = v[0]; T[kl * 65 + n4 + 1] = v[1]; T[kl * 65 + n4 + 2] = v[2]; T[kl * 65 + n4 + 3] = v[3];
  }
  __syncthreads();
  const int nl = tid >> 2, kq = tid & 3, n = nt * 64 + nl;
  if (n < N) {
    const int drow = map_row(mode, aux, n);
    unsigned w[8];
#pragma unroll
    for (int e = 0; e < 8; ++e) w[e] = pk2(T[(kq * 16 + 2 * e) * 65 + nl], T[(kq * 16 + 2 * e + 1) * 65 + nl]);
    bf16_t* dp = dst + (size_t)drow * dst_ld + kt * 64 + kq * 16;
    *(u32x4*)dp = (u32x4){w[0], w[1], w[2], w[3]};
    *(u32x4*)(dp + 8) = (u32x4){w[4], w[5], w[6], w[7]};
  }
  __syncthreads();
}

constexpr int TRN0 = 16 * 83, TRN1 = 6 * 12, TRN2 = 4 * 16, TRN45 = 160, TRN3 = 8 * 16, TRN6 = 20 * 16, TRN7 = 16 * 16, TRN8 = 16 * 88, TRN9 = 44 * 16;
constexpr int TR_EARLY = TRN0 + TRN1 + TRN2 + TRN45;
constexpr int TR_ALL = TR_EARLY + TRN3 + TRN6 + TRN7 + TRN8 + TRN9;
DI void transpose_job(const P& p, int t, char* lds, int tid) {
  if (t < TRN0) { transpose_tile(p.w_in, 1024, IN_DIM, t % 16, t / 16, (bf16_t*)(p.ws + OFF_WIN), 1024, 1, 0, nullptr, lds, tid); return; }
  t -= TRN0;
  if (t < TRN1) { transpose_tile(p.w_uq, 384, 768, t % 6, t / 6, (bf16_t*)(p.ws + OFF_WUQ), 384, 0, 0, p.q_norm_g, lds, tid); return; }
  t -= TRN1;
  if (t < TRN2) { transpose_tile(p.w_ukv, 256, 1024, t % 4, t / 4, (bf16_t*)(p.ws + OFF_WUKV), 256, 0, 0, p.kv_norm_g, lds, tid); return; }
  t -= TRN2;
  if (t < TRN45) {
    const int gate = t >= 80 ? 1 : 0; const int tt = t - gate * 80;
    const int mat = tt >> 2, sub4 = tt & 3;
    const int dir = mat / 10, cb = mat % 10;
    const float* src = (gate ? p.lru_w_x : p.lru_w_a) + (size_t)mat * 128 * 128;
    transpose_tile(src, 128, 128, sub4 & 1, sub4 >> 1, (bf16_t*)(p.ws + OFF_GATES), 128, 2, cb * 4 + dir * 2 + gate, nullptr, lds, tid); return;
  }
  t -= TRN45;
  if (t < TRN3) { transpose_tile(p.w_o_attn, 512, 1024, t % 8, t / 8, (bf16_t*)(p.ws + OFF_WOA), 512, 0, 0, nullptr, lds, tid); return; }
  t -= TRN3;
  if (t < TRN6) { transpose_tile(p.w_o_lru, 1280, 1024, t % 20, t / 20, (bf16_t*)(p.ws + OFF_WOL), 1280, 0, 0, nullptr, lds, tid); return; }
  t -= TRN6;
  if (t < TRN7) { transpose_tile(p.w_out, 1024, 1024, t % 16, t / 16, (bf16_t*)(p.ws + OFF_WOUT), 1024, 0, 0, nullptr, lds, tid); return; }
  t -= TRN7;
  if (t < TRN8) { transpose_tile(p.w_up, 1024, 2 * FFN, t % 16, t / 16, (bf16_t*)(p.ws + OFF_WUP), 1024, 3, 0, nullptr, lds, tid); return; }
  t -= TRN8;
  transpose_tile(p.w_down, FFN, 1024, t % 44, t / 44, (bf16_t*)(p.ws + OFF_WD), FFN, 0, 0, nullptr, lds, tid);
}

DI void phase0(const P& p, char* lds, int tid) {
  bf16_t* WIN = (bf16_t*)(p.ws + OFF_WIN);
  constexpr int N_MODP = 384;
  constexpr int N_TR = TR_EARLY;
  constexpr int N_MISC = 64 + 3 + 12;
  constexpr int N_ITEMS = N_MODP + N_TR + N_MISC;
  for (int it = blockIdx.x; it < N_ITEMS; it += gridDim.x) {
    if (it < N_MODP) {
      const int ng = it % 48, pk = it / 48;
      float* sv = (float*)lds;
      float* red = sv + 640;
      for (int i = tid; i < 640; i += 256) {
        const int bi = i >> 7, kk = i & 127, k = pk * 128 + kk;
        const float cv = bi < 4 ? p.c[bi * 1024 + k] : p.c_ctx[k];
        sv[i] = cv * sigm(cv);
      }
      __syncthreads();
      const int col = tid & 127, kh = tid >> 7;
      float a0 = 0.f, a1 = 0.f, a2 = 0.f, a3 = 0.f, a4 = 0.f;
      const float* wp = p.w_mod + (size_t)(pk * 128 + kh * 64) * 6144 + ng * 128 + col;
      const float* svh = sv + kh * 64;
#pragma unroll 16
      for (int kk = 0; kk < 64; ++kk) {
        const float w = wp[(size_t)kk * 6144];
        a0 += svh[kk] * w; a1 += svh[128 + kk] * w; a2 += svh[256 + kk] * w; a3 += svh[384 + kk] * w; a4 += svh[512 + kk] * w;
      }
      if (kh == 1) { red[col] = a0; red[128 + col] = a1; red[256 + col] = a2; red[384 + col] = a3; red[512 + col] = a4; }
      __syncthreads();
      if (kh == 0) {
        float* mp = (float*)(p.ws + OFF_MODP) + (size_t)(pk * 5) * 6144 + ng * 128 + col;
        mp[0] = a0 + red[col]; mp[6144] = a1 + red[128 + col]; mp[2 * 6144] = a2 + red[256 + col]; mp[3 * 6144] = a3 + red[384 + col]; mp[4 * 6144] = a4 + red[512 + col];
      }
      __syncthreads();
    } else if (it < N_MODP + N_TR) {
      transpose_job(p, it - N_MODP, lds, tid);
    } else {
      int t = it - N_MODP - N_TR;
      if (t < 64) {
#pragma unroll
        for (int e = 0; e < 4; ++e) {
          const int idx = t * 1024 + e * 256 + tid; const int s = idx >> 4, i = idx & 15;
          const float pos = (float)((i < 8) ? (s >> 6) : (s & 63));
          const float inv = 1.0f / powf(10000.0f, (float)(2 * (i & 7)) / 16.0f);
          const float ang = pos * inv;
          float* rp = (float*)(p.ws + OFF_ROPE) + (size_t)idx * 2;
          rp[0] = cosf(ang); rp[1] = sinf(ang);
        }
      } else if (t < 67) {
        const int idx0 = (t - 64) * 1024;
#pragma unroll
        for (int e = 0; e < 4; ++e) {
          const int idx = idx0 + e * 256 + tid;
          if (idx < 2 * LW) ((float*)(p.ws + OFF_SP))[idx] = log1pf(expf(-p.lru_lambda[idx]));
        }
      } else {
        const int idx0 = (t - 67) * 1024;
#pragma unroll
        for (int e = 0; e < 4; ++e) {
          const int idx = idx0 + e * 256 + tid;
          *(u32x4*)((char*)(WIN + (size_t)3232 * 1024) + (size_t)idx * 16) = (u32x4){0u, 0u, 0u, 0u};
        }
      }
    }
  }
}

DI void phase1(const P& p, char* lds, int tid) {
  const float* MODP = (const float*)(p.ws + OFF_MODP);
  const int lane = tid & 63, wid = tid >> 6;
  for (int it = blockIdx.x; it < 544 + 34 + (TR_ALL - TR_EARLY); it += gridDim.x) {
    if (it >= 544 + 34) { transpose_job(p, TR_EARLY + (it - 578), lds, tid); continue; }
    if (it < 544) {
      const int t0 = it * 32;
      const int bi = t0 < TL ? (t0 >> 12) : 4;
      float* gs = (float*)lds; float* sh = gs + 1024;
      {
        const int k = tid * 4;
        f32x4 a = *(const f32x4*)(p.b_mod + k), b = *(const f32x4*)(p.b_mod + 1024 + k);
#pragma unroll
        for (int pp = 0; pp < 8; ++pp) {
          a += *(const f32x4*)(MODP + (size_t)(pp * 5 + bi) * 6144 + k);
          b += *(const f32x4*)(MODP + (size_t)(pp * 5 + bi) * 6144 + 1024 + k);
        }
        const f32x4 g = *(const f32x4*)(p.norm1_g + k);
        *(f32x4*)(sh + k) = a;
        *(f32x4*)(gs + k) = g * (1.f + b);
      }
      __syncthreads();
      for (int tt = 0; tt < 8; ++tt) {
        const int t = t0 + wid * 8 + tt;
        const float* src = t < TL ? p.x + (size_t)t * 1024 : p.ctx + (size_t)(t - TL) * 1024;
        f32x4 v[4]; float ss = 0.f;
#pragma unroll
        for (int i = 0; i < 4; ++i) { v[i] = *(const f32x4*)(src + i * 256 + lane * 4); ss += v[i][0] * v[i][0] + v[i][1] * v[i][1] + v[i][2] * v[i][2] + v[i][3] * v[i][3]; }
        ss = wave_sum(ss);
        const float rs = rsqrtf(ss * (1.f / 1024.f) + EPS);
        bf16_t* dp = (bf16_t*)(p.ws + OFF_H1) + (size_t)t * 1024;
#pragma unroll
        for (int i = 0; i < 4; ++i) {
          const int k = i * 256 + lane * 4;
          const f32x4 g = *(const f32x4*)(gs + k), s = *(const f32x4*)(sh + k);
          const f32x4 y = v[i] * rs * g + s;
          *(u32x2*)(dp + k) = (u32x2){pk2(y[0], y[1]), pk2(y[2], y[3])};
        }
      }
      __syncthreads();
    } else {
      const int fi = it - 544;
#pragma unroll
      for (int e = 0; e < 4; ++e) {
        const int idx = fi * 1024 + tid * 4 + e;
        if (idx < 30720) {
          const int bi = idx / 6144, n = idx - bi * 6144;
          float a = p.b_mod[n];
#pragma unroll
          for (int pp = 0; pp < 8; ++pp) a += MODP[(size_t)(pp * 5 + bi) * 6144 + n];
          ((float*)(p.ws + OFF_MOD))[idx] = a;
        } else {
          const int i2 = idx - 30720, b = i2 >> 10, k = i2 & 1023;
          float a = p.b_mod[4096 + k];
#pragma unroll
          for (int pp = 0; pp < 8; ++pp) a += MODP[(size_t)(pp * 5 + b) * 6144 + 4096 + k];
          ((float*)(p.ws + OFF_GS2))[i2] = p.norm2_g[k] * (1.f + a);
        }
      }
    }
  }
}

DI void phase2(const P& p, char* lds, int tid) {
  const int lane = tid & 63, wid = tid >> 6, wr = wid >> 1, wc = wid & 1, fr = lane & 15, fq = lane >> 4;
  const bf16_t* H1 = (const bf16_t*)(p.ws + OFF_H1);
  const bf16_t* WIN = (const bf16_t*)(p.ws + OFF_WIN);
  bf16_t* Z = (bf16_t*)(p.ws + OFF_Z);
  float* SSQ1 = (float*)(p.ws + OFF_SSQ1);
  for (int t = blockIdx.x; t < tile_rect_count(136, NT_Z); t += gridDim.x) {
    int m, n; if (!tile_rect(t, 136, NT_Z, m, n)) continue;
    if (m >= 128 && (n < 3 || (n >= 15 && n < 25))) continue;
    f32x4 acc[4][4]; zero_acc(acc);
    LoadPlain la{H1 + (size_t)m * 128 * 1024, 1024};
    gemm_k<true>(acc, la, WIN + (size_t)n * 128 * 1024, 1024, 1024, lds, tid);
#pragma unroll
    for (int mm = 0; mm < 4; ++mm) {
      const int row = m * 128 + wr * 64 + mm * 16 + fr;
      float ss = 0.f;
#pragma unroll
      for (int nn = 0; nn < 4; ++nn) {
        const f32x4 v = acc[mm][nn];
        ss += v[0] * v[0] + v[1] * v[1] + v[2] * v[2] + v[3] * v[3];
        const u32x2 pv = (u32x2){pk2(v[0], v[1]), pk2(v[2], v[3])};
        *(u32x2*)(Z + (size_t)row * ZLD + n * 128 + wc * 64 + nn * 16 + fq * 4) = pv;
        if (n >= 5 && n < 15) {
          const int r6 = row & 63;
          if (r6 == 0 || r6 >= 62) {
            const int slot = r6 == 0 ? 0 : r6 - 61;
            *(u32x2*)((bf16_t*)(p.ws + OFF_HALO) + ((size_t)(row >> 6) * 3 + slot) * LW + (n - 5) * 128 + wc * 64 + nn * 16 + fq * 4) = pv;
          }
        }
      }
      if (n < 5) {
        ss += __shfl_xor(ss, 16); ss += __shfl_xor(ss, 32);
        if (fq == 0) SSQ1[(size_t)row * 10 + n * 2 + wc] = ss;
      }
    }
  }
}

DI void unpack8(const u32x4 v, float (&o)[8]) {
  o[0] = bflo(v[0]); o[1] = bfhi(v[0]); o[2] = bflo(v[1]); o[3] = bfhi(v[1]); o[4] = bflo(v[2]); o[5] = bfhi(v[2]); o[6] = bflo(v[3]); o[7] = bfhi(v[3]);
}
DI void conv_chunks(const P& p, int c, int tid) {
  bf16_t* Z = (bf16_t*)(p.ws + OFF_Z);
  const bf16_t* HALO = (const bf16_t*)(p.ws + OFF_HALO);
  if (tid >= 160) return;
  const int ch = tid * 8;
  float w[4][8], bias[8];
#pragma unroll
  for (int kk = 0; kk < 4; ++kk) {
    const f32x4 a = *(const f32x4*)(p.lru_conv_w + kk * LW + ch), b = *(const f32x4*)(p.lru_conv_w + kk * LW + ch + 4);
    w[kk][0] = a[0]; w[kk][1] = a[1]; w[kk][2] = a[2]; w[kk][3] = a[3]; w[kk][4] = b[0]; w[kk][5] = b[1]; w[kk][6] = b[2]; w[kk][7] = b[3];
  }
  { const f32x4 a = *(const f32x4*)(p.lru_conv_b + ch), b = *(const f32x4*)(p.lru_conv_b + ch + 4);
    bias[0] = a[0]; bias[1] = a[1]; bias[2] = a[2]; bias[3] = a[3]; bias[4] = b[0]; bias[5] = b[1]; bias[6] = b[2]; bias[7] = b[3]; }
  {
    const int r0 = c * 64;
    int seq0, seqlen;
    if (r0 < TL) { seq0 = r0 & ~4095; seqlen = S; } else { seq0 = TL + ((r0 - TL) & ~255); seqlen = CL; }
    const u32x4 zero4 = (u32x4){0u, 0u, 0u, 0u};
    u32x4 xm2 = zero4, xm1 = zero4;
    if (r0 > seq0) { xm2 = *(const u32x4*)(HALO + ((size_t)(c - 1) * 3 + 1) * LW + ch); xm1 = *(const u32x4*)(HALO + ((size_t)(c - 1) * 3 + 2) * LW + ch); }
    u32x4 nxt = zero4;
    if (r0 + 64 < seq0 + seqlen) nxt = *(const u32x4*)(HALO + ((size_t)(c + 1) * 3 + 0) * LW + ch);
    bf16_t* zp = Z + (size_t)r0 * ZLD + ZC_XB + ch;
#pragma unroll 1
    for (int bt = 0; bt < 8; ++bt) {
      u32x4 cur[9];
#pragma unroll
      for (int i = 0; i < 8; ++i) cur[i] = *(const u32x4*)(zp + (size_t)(bt * 8 + i) * ZLD);
      cur[8] = (bt < 7) ? *(const u32x4*)(zp + (size_t)(bt * 8 + 8) * ZLD) : nxt;
#pragma unroll
      for (int i = 0; i < 8; ++i) {
        float a[8], b[8], cc[8], d[8], o[8];
        unpack8(xm2, a); unpack8(xm1, b); unpack8(cur[i], cc); unpack8(cur[i + 1], d);
#pragma unroll
        for (int e = 0; e < 8; ++e) o[e] = bias[e] + w[0][e] * a[e] + w[1][e] * b[e] + w[2][e] * cc[e] + w[3][e] * d[e];
        *(u32x4*)(zp + (size_t)(bt * 8 + i) * ZLD) = (u32x4){pk2(o[0], o[1]), pk2(o[2], o[3]), pk2(o[4], o[5]), pk2(o[6], o[7])};
        xm2 = xm1; xm1 = cur[i];
      }
    }
  }
}

template <int PASS>
DI void gates_tile(const P& p, int mt, int nt, char* lds, int tid) {
  const int lane = tid & 63, wid = tid >> 6, wr = wid >> 1, wc = wid & 1, fr = lane & 15, fq = lane >> 4;
  bf16_t* Z = (bf16_t*)(p.ws + OFF_Z);
  const float* SP = (const float*)(p.ws + OFF_SP);
  float* SUM = (float*)(p.ws + OFF_SUM);
  float* XS = (float*)(lds + LDS_X);
  float* TCAR = (float*)(lds + LDS_X + 2048);
  const int m0 = mt * 128;
  const int cb = nt >> 2;
  if (PASS == 2) {
    if (tid < 64) TCAR[tid] = ((const float*)(p.ws + OFF_CAR))[((size_t)(tid >> 5) * 128 + mt) * LW + nt * 32 + (tid & 31)];
  }
  f32x4 acc[4][4]; zero_acc(acc);
  LoadPlain la{Z + (size_t)m0 * ZLD + ZC_XB + cb * 128, ZLD};
  gemm_k<true>(acc, la, (const bf16_t*)(p.ws + OFF_GATES) + (size_t)nt * 128 * 128, 128, 128, lds, tid);
  {
    const int chl0 = wc * 16 + fq * 4, ch = nt * 32 + chl0;
    f32x4 xc[4];
#pragma unroll
    for (int mm = 0; mm < 4; ++mm) {
      const u32x2 xv = *(const u32x2*)(Z + (size_t)(m0 + wr * 64 + mm * 16 + fr) * ZLD + ZC_XB + ch);
      xc[mm] = (f32x4){bflo(xv[0]), bfhi(xv[0]), bflo(xv[1]), bfhi(xv[1])};
    }
    float* LAf = (float*)lds; float* Uf = LAf + 4096; float* LAb = LAf + 8192; float* Ub = LAf + 12288;
    {
      const f32x4 baf = *(const f32x4*)(p.lru_b_a + ch) * -1.4426950408889634f, bxf = *(const f32x4*)(p.lru_b_x + ch) * -1.4426950408889634f,
                  spf = *(const f32x4*)(SP + ch) * (-8.f * 1.4426950408889634f);
#pragma unroll
      for (int mm = 0; mm < 4; ++mm) {
        const int rl = wr * 64 + mm * 16 + fr;
        f32x4 laf, uf;
#pragma unroll
        for (int j = 0; j < 4; ++j) {
          const float er = 1.f + __builtin_amdgcn_exp2f(__builtin_fmaf(acc[mm][0][j], -1.4426950408889634f, baf[j]));
          const float ei = 1.f + __builtin_amdgcn_exp2f(__builtin_fmaf(acc[mm][1][j], -1.4426950408889634f, bxf[j]));
          const float inv = __builtin_amdgcn_rcpf(er * ei);
          const float rf = inv * ei, xf = inv * er;
          const float a = __builtin_amdgcn_exp2f(rf * spf[j]);
          laf[j] = a;
          uf[j] = __builtin_amdgcn_sqrtf(fmaxf(1.f - a * a, 0.f)) * xf * xc[mm][j];
        }
        *(f32x4*)(LAf + rl * 32 + chl0) = laf; *(f32x4*)(Uf + rl * 32 + chl0) = uf;
      }
    }
    {
      const f32x4 bab = *(const f32x4*)(p.lru_b_a + LW + ch) * -1.4426950408889634f, bxb = *(const f32x4*)(p.lru_b_x + LW + ch) * -1.4426950408889634f,
                  spb = *(const f32x4*)(SP + LW + ch) * (-8.f * 1.4426950408889634f);
#pragma unroll
      for (int mm = 0; mm < 4; ++mm) {
        const int rl = wr * 64 + mm * 16 + fr;
        f32x4 lab, ub;
#pragma unroll
        for (int j = 0; j < 4; ++j) {
          const float er = 1.f + __builtin_amdgcn_exp2f(__builtin_fmaf(acc[mm][2][j], -1.4426950408889634f, bab[j]));
          const float ei = 1.f + __builtin_amdgcn_exp2f(__builtin_fmaf(acc[mm][3][j], -1.4426950408889634f, bxb[j]));
          const float inv = __builtin_amdgcn_rcpf(er * ei);
          const float rb = inv * ei, xb = inv * er;
          const float a = __builtin_amdgcn_exp2f(rb * spb[j]);
          lab[j] = a;
          ub[j] = __builtin_amdgcn_sqrtf(fmaxf(1.f - a * a, 0.f)) * xb * xc[mm][j];
        }
        *(f32x4*)(LAb + rl * 32 + chl0) = lab; *(f32x4*)(Ub + rl * 32 + chl0) = ub;
      }
    }
  }
  __syncthreads();
  const int chain = tid & 63, dir = chain >> 5, chl = chain & 31, seg = tid >> 6;
  float* LA = (float*)lds + dir * 8192; float* U = LA + 4096;
  const int rbase = dir ? 127 - seg * 32 : seg * 32, rstep = dir ? -1 : 1;
  float hh = 0.f, cum = 1.f;
#pragma unroll 1
  for (int hf = 0; hf < 2; ++hf) {
    float la_[16], u_[16];
#pragma unroll
    for (int i = 0; i < 16; ++i) { const int rl = rbase + rstep * (hf * 16 + i); la_[i] = LA[rl * 32 + chl]; u_[i] = U[rl * 32 + chl]; }
#pragma unroll
    for (int i = 0; i < 16; ++i) {
      cum *= la_[i]; hh = la_[i] * hh + u_[i];
      if (PASS == 2) { const int rl = rbase + rstep * (hf * 16 + i); LA[rl * 32 + chl] = cum; U[rl * 32 + chl] = hh; }
    }
  }
  XS[((dir * 4 + seg) * 32 + chl) * 2] = cum; XS[((dir * 4 + seg) * 32 + chl) * 2 + 1] = hh;
  __syncthreads();
  float cy = (PASS == 2) ? TCAR[chain] : 0.f;
  float ccum = 1.f;
#pragma unroll
  for (int s2 = 0; s2 < 3; ++s2) {
    if (s2 < seg) { const float cs = XS[((dir * 4 + s2) * 32 + chl) * 2], hs = XS[((dir * 4 + s2) * 32 + chl) * 2 + 1]; cy = hs + cs * cy; ccum *= cs; }
  }
  if (PASS == 1) {
    if (seg == 3) {
      float* sp = SUM + (((size_t)dir * 136 + mt) * LW + nt * 32 + chl) * 2;
      sp[0] = ccum * cum; sp[1] = hh + cum * cy;
    }
    __syncthreads();
  } else {
#pragma unroll 8
    for (int i = 0; i < 32; ++i) { const int rl = rbase + rstep * i; U[rl * 32 + chl] += LA[rl * 32 + chl] * cy; }
    __syncthreads();
    {
      const int rl = tid >> 1, c16 = (tid & 1) * 16;
      const float* Uf = (const float*)lds + 4096; const float* Ub = (const float*)lds + 12288;
#pragma unroll 1
      for (int hf = 0; hf < 2; ++hf) {
        bf16_t* yp = Z + (size_t)(m0 + rl) * ZLD + ZC_YB + nt * 32 + c16 + hf * 8;
        const u32x4 y0 = *(const u32x4*)yp;
        const f32x4 fa = *(const f32x4*)(Uf + rl * 32 + c16 + hf * 8), fb = *(const f32x4*)(Uf + rl * 32 + c16 + hf * 8 + 4);
        const f32x4 ba = *(const f32x4*)(Ub + rl * 32 + c16 + hf * 8), bb = *(const f32x4*)(Ub + rl * 32 + c16 + hf * 8 + 4);
        u32x4 o;
        o[0] = pk2((fa[0] + ba[0]) * gelu_tanh(bflo(y0[0])), (fa[1] + ba[1]) * gelu_tanh(bfhi(y0[0])));
        o[1] = pk2((fa[2] + ba[2]) * gelu_tanh(bflo(y0[1])), (fa[3] + ba[3]) * gelu_tanh(bfhi(y0[1])));
        o[2] = pk2((fb[0] + bb[0]) * gelu_tanh(bflo(y0[2])), (fb[1] + bb[1]) * gelu_tanh(bfhi(y0[2])));
        o[3] = pk2((fb[2] + bb[2]) * gelu_tanh(bflo(y0[3])), (fb[3] + bb[3]) * gelu_tanh(bfhi(y0[3])));
        *(u32x4*)yp = o;
      }
    }
    __syncthreads();
  }
}

DI void row_bk(int row, int& b, int& key) {
  if (row < TL) { b = row >> 12; key = row & 4095; } else { const int r2 = row - TL; b = r2 >> 8; key = S + (r2 & 255); }
}

DI void kv_tile(const P& p, int m, int h, char* lds, int tid) {
  const int lane = tid & 63, wid = tid >> 6, wr = wid >> 1, wc = wid & 1, fr = lane & 15, fq = lane >> 4;
  const bf16_t* Z = (const bf16_t*)(p.ws + OFF_Z);
  const float* SSQ1 = (const float*)(p.ws + OFF_SSQ1);
  bf16_t* KB = (bf16_t*)(p.ws + OFF_KB); bf16_t* VT = (bf16_t*)(p.ws + OFF_VT);
  f32x4 acc[4][4]; zero_acc(acc);
  LoadPlain la{Z + (size_t)m * 128 * ZLD + ZC_KVL, ZLD};
  gemm_k<false>(acc, la, (const bf16_t*)(p.ws + OFF_WUKV) + (size_t)h * 128 * 256, 256, 256, lds, tid);
#pragma unroll
  for (int mm = 0; mm < 4; ++mm) {
    const int row = m * 128 + wr * 64 + mm * 16 + fr;
    const float* sq = SSQ1 + (size_t)row * 10 + 6;
    const float rs = rsqrtf((sq[0] + sq[1] + sq[2] + sq[3]) * (1.f / 256.f) + EPS);
    int b, key; row_bk(row, b, key);
#pragma unroll
    for (int nn = 0; nn < 4; ++nn) {
      const f32x4 v = acc[mm][nn] * rs;
      const int d = nn * 16 + fq * 4;
      if (wc == 0) {
        *(u32x2*)(KB + ((size_t)(b * NH + h) * NKEY + key) * QKD + d) = (u32x2){pk2(v[0], v[1]), pk2(v[2], v[3])};
      } else {
        bf16_t* vp = VT + ((size_t)(b * NH + h) * VD + d) * NKEY + key;
        const unsigned w0 = pk2(v[0], v[1]), w1 = pk2(v[2], v[3]);
        vp[0] = (bf16_t)(w0 & 0xffffu); vp[NKEY] = (bf16_t)(w0 >> 16); vp[2 * NKEY] = (bf16_t)(w1 & 0xffffu); vp[3 * NKEY] = (bf16_t)(w1 >> 16);
      }
    }
  }
  {
    const int rl = tid >> 1, half = tid & 1, row = m * 128 + rl;
    int b, key; row_bk(row, b, key);
    const bf16_t* kr = Z + (size_t)row * ZLD + ZC_KR + half * 8;
    const u32x4 a1 = *(const u32x4*)kr, a2 = *(const u32x4*)(kr + 16);
    float x1[8] = {bflo(a1[0]), bfhi(a1[0]), bflo(a1[1]), bfhi(a1[1]), bflo(a1[2]), bfhi(a1[2]), bflo(a1[3]), bfhi(a1[3])};
    float x2[8] = {bflo(a2[0]), bfhi(a2[0]), bflo(a2[1]), bfhi(a2[1]), bflo(a2[2]), bfhi(a2[2]), bflo(a2[3]), bfhi(a2[3])};
    float o1[8], o2[8];
    if (row < TL) {
      const float* rp = (const float*)(p.ws + OFF_ROPE) + ((size_t)key * 16 + half * 8) * 2;
#pragma unroll
      for (int e = 0; e < 8; ++e) { const float cs = rp[2 * e], sn = rp[2 * e + 1]; o1[e] = x1[e] * cs - x2[e] * sn; o2[e] = x2[e] * cs + x1[e] * sn; }
    } else {
#pragma unroll
      for (int e = 0; e < 8; ++e) { o1[e] = x1[e]; o2[e] = x2[e]; }
    }
    bf16_t* kp = KB + ((size_t)(b * NH + h) * NKEY + key) * QKD + 64 + half * 8;
    *(u32x4*)kp = (u32x4){pk2(o1[0], o1[1]), pk2(o1[2], o1[3]), pk2(o1[4], o1[5]), pk2(o1[6], o1[7])};
    *(u32x4*)(kp + 16) = (u32x4){pk2(o2[0], o2[1]), pk2(o2[2], o2[3]), pk2(o2[4], o2[5]), pk2(o2[6], o2[7])};
  }
}

DI void q_tile(const P& p, int m, int n, char* lds, int tid) {
  const int lane = tid & 63, wid = tid >> 6, wr = wid >> 1, wc = wid & 1, fr = lane & 15, fq = lane >> 4;
  const bf16_t* Z = (const bf16_t*)(p.ws + OFF_Z);
  const float* SSQ1 = (const float*)(p.ws + OFF_SSQ1);
  bf16_t* Q = (bf16_t*)(p.ws + OFF_Q);
  f32x4 acc[4][4]; zero_acc(acc);
  LoadPlain la{Z + (size_t)m * 128 * ZLD + ZC_QL, ZLD};
  gemm_k<false>(acc, la, (const bf16_t*)(p.ws + OFF_WUQ) + (size_t)n * 128 * 384, 384, 384, lds, tid);
  const float qscale = 0.10206207261596577f * 1.4426950408889634f;
#pragma unroll
  for (int mm = 0; mm < 4; ++mm) {
    const int row = m * 128 + wr * 64 + mm * 16 + fr;
    const float* sq = SSQ1 + (size_t)row * 10;
    const float rs = rsqrtf((sq[0] + sq[1] + sq[2] + sq[3] + sq[4] + sq[5]) * (1.f / 384.f) + EPS) * qscale;
    const int b = row >> 12, s = row & 4095;
    f32x4 v[4];
#pragma unroll
    for (int nn = 0; nn < 4; ++nn) v[nn] = acc[mm][nn] * rs;
#pragma unroll
    for (int nn = 0; nn < 4; nn += 2) {
      const int c0 = n * 128 + wc * 64 + nn * 16;
      const int d0 = c0 % 96;
      if (d0 == 64) {
        const float* rp = (const float*)(p.ws + OFF_ROPE) + ((size_t)s * 16 + fq * 4) * 2;
        f32x4 a = v[nn], bq = v[nn + 1];
#pragma unroll
        for (int j = 0; j < 4; ++j) { const float cs = rp[2 * j], sn = rp[2 * j + 1]; v[nn][j] = a[j] * cs - bq[j] * sn; v[nn + 1][j] = bq[j] * cs + a[j] * sn; }
      }
    }
#pragma unroll
    for (int nn = 0; nn < 4; ++nn) {
      const int c = n * 128 + wc * 64 + nn * 16 + fq * 4;
      const int hh = c / 96, d = c - hh * 96;
      *(u32x2*)(Q + ((size_t)(b * NH + hh) * S + s) * QKD + d) = (u32x2){pk2(v[nn][0], v[nn][1]), pk2(v[nn][2], v[nn][3])};
    }
  }
}

DI void phase25(const P& p, char* lds, int tid) {
  constexpr int NC = TT / 64, NKV = 136 * 8, NQ = 128 * 6;
  for (int it = blockIdx.x; it < NC + NKV + NQ; it += gridDim.x) {
    if (it < NC) conv_chunks(p, it, tid);
    else if (it < NC + NKV) { int m, n; tile_mn(it - NC, 136, 8, m, n); kv_tile(p, m, n, lds, tid); }
    else { int m, n; tile_mn(it - NC - NKV, 128, 6, m, n); q_tile(p, m, n, lds, tid); }
  }
}
DI void phase3(const P& p, char* lds, int tid) {
  for (int it = blockIdx.x; it < 136 * 40; it += gridDim.x) { int m, n; tile_mn(it, 136, 40, m, n); gates_tile<1>(p, m, n, lds, tid); }
}

DI int swap23(int i) { return (i & 0x13) | ((i & 4) << 1) | ((i & 8) >> 1); }

DI void attn_soft(f32x16& S0, f32x16& O0, f32x16& O1, float& mrun, float& lrun, bool first) {
  float mx = fmaxf(fmaxf(S0[0], S0[1]), S0[2]);
#pragma unroll
  for (int i = 3; i < 15; i += 2) mx = fmaxf(fmaxf(mx, S0[i]), S0[i + 1]);
  mx = fmaxf(mx, S0[15]);
  if (first || __any(mx > 8.0f)) {
    mx = fmaxf(mx, __shfl_xor(mx, 32));
    const float delta = first ? mx : fmaxf(mx, 0.f);
    const float alpha = __builtin_amdgcn_exp2f(-delta);
    mrun += delta; lrun *= alpha;
#pragma unroll
    for (int i = 0; i < 16; ++i) { O0[i] *= alpha; O1[i] *= alpha; S0[i] -= delta; }
  }
  float rsum = 0.f;
#pragma unroll
  for (int i = 0; i < 16; ++i) { S0[i] = __builtin_amdgcn_exp2f(S0[i]); rsum += S0[i]; }
  lrun += rsum;
}
DI void attn_sub2(const char* stg, int kfo, int vfo, int sub, const bf16x8 (&qfa)[6], const bf16x8 (&qfb)[6],
                  f32x16& O0a, f32x16& O1a, f32x16& O0b, f32x16& O1b, float& mruna, float& lruna, float& mrunb, float& lrunb, bool first) {
  f32x16 Sa, Sb;
  { const float na = -mruna, nb = -mrunb;
#pragma unroll
    for (int i = 0; i < 16; ++i) { Sa[i] = na; Sb[i] = nb; } }
#pragma unroll
  for (int s = 0; s < 6; ++s) {
    const bf16x8 kf = *(const bf16x8*)(stg + kfo + sub * (32 * 208) + s * 32);
    Sa = __builtin_amdgcn_mfma_f32_32x32x16_bf16(kf, qfa[s], Sa, 0, 0, 0);
    Sb = __builtin_amdgcn_mfma_f32_32x32x16_bf16(kf, qfb[s], Sb, 0, 0, 0);
  }
  attn_soft(Sa, O0a, O1a, mruna, lruna, first);
  attn_soft(Sb, O0b, O1b, mrunb, lrunb, first);
#pragma unroll
  for (int s = 0; s < 2; ++s) {
    const u32x4 pa = (u32x4){pk2(Sa[8 * s], Sa[8 * s + 1]), pk2(Sa[8 * s + 2], Sa[8 * s + 3]), pk2(Sa[8 * s + 4], Sa[8 * s + 5]), pk2(Sa[8 * s + 6], Sa[8 * s + 7])};
    const u32x4 pb = (u32x4){pk2(Sb[8 * s], Sb[8 * s + 1]), pk2(Sb[8 * s + 2], Sb[8 * s + 3]), pk2(Sb[8 * s + 4], Sb[8 * s + 5]), pk2(Sb[8 * s + 6], Sb[8 * s + 7])};
    const bf16x8 pfa = __builtin_bit_cast(bf16x8, pa), pfb = __builtin_bit_cast(bf16x8, pb);
    const bf16x8 v0f = *(const bf16x8*)(stg + vfo + sub * 64 + s * 32);
    const bf16x8 v1f = *(const bf16x8*)(stg + vfo + 32 * 144 + sub * 64 + s * 32);
    O0a = __builtin_amdgcn_mfma_f32_32x32x16_bf16(v0f, pfa, O0a, 0, 0, 0);
    O1a = __builtin_amdgcn_mfma_f32_32x32x16_bf16(v1f, pfa, O1a, 0, 0, 0);
    O0b = __builtin_amdgcn_mfma_f32_32x32x16_bf16(v0f, pfb, O0b, 0, 0, 0);
    O1b = __builtin_amdgcn_mfma_f32_32x32x16_bf16(v1f, pfb, O1b, 0, 0, 0);
  }
}
DI void attn_store(bf16_t* op, int hh, const f32x16& O0, const f32x16& O1, float lrun) {
  lrun += __shfl_xor(lrun, 32);
  const float il = 1.f / lrun;
#pragma unroll
  for (int g = 0; g < 4; ++g) {
    *(u32x2*)(op + 8 * g + 4 * hh) = (u32x2){pk2(O0[4 * g] * il, O0[4 * g + 1] * il), pk2(O0[4 * g + 2] * il, O0[4 * g + 3] * il)};
    *(u32x2*)(op + 32 + 8 * g + 4 * hh) = (u32x2){pk2(O1[4 * g] * il, O1[4 * g + 1] * il), pk2(O1[4 * g + 2] * il, O1[4 * g + 3] * il)};
  }
}
DI void attn_item(const P& p, int b, int h, int qb, char* lds, int tid) {
  const int lane = tid & 63, wid = tid >> 6, r = lane & 31, hh = lane >> 5;
  bf16_t* Qit = (bf16_t*)(p.ws + OFF_Q) + ((size_t)(b * NH + h) * S + qb * 256) * QKD;
  const bf16_t* Kg = (const bf16_t*)(p.ws + OFF_KB) + (size_t)(b * NH + h) * NKEY * QKD;
  const bf16_t* Vg = (const bf16_t*)(p.ws + OFF_VT) + (size_t)(b * NH + h) * VD * NKEY;
  bf16x8 qfa[6], qfb[6];
#pragma unroll
  for (int s = 0; s < 6; ++s) {
    qfa[s] = *(const bf16x8*)(Qit + (size_t)(wid * 64 + r) * QKD + 16 * s + 8 * hh);
    qfb[s] = *(const bf16x8*)(Qit + (size_t)(wid * 64 + 32 + r) * QKD + 16 * s + 8 * hh);
  }
  f32x16 O0a, O1a, O0b, O1b;
#pragma unroll
  for (int i = 0; i < 16; ++i) { O0a[i] = 0.f; O1a[i] = 0.f; O0b[i] = 0.f; O1b[i] = 0.f; }
  float mruna = 0.f, lruna = 0.f, mrunb = 0.f, lrunb = 0.f;
  constexpr int KSTG = 64 * 208 + 64 * 144;
  const int kq0 = tid, kq1 = tid + 256, kq2 = tid + 512;
  const int kr0 = kq0 / 12, kc0 = kq0 % 12, kr1 = kq1 / 12, kc1 = kq1 % 12, kr2 = kq2 / 12, kc2 = kq2 % 12;
  const int vd0 = tid >> 3, vc0 = tid & 7;
  u32x4 pk0, pk1_, pk2_, pv0, pv1;
  const __amdgpu_buffer_rsrc_t rsk = make_rsrc(Kg), rsv = make_rsrc(Vg);
  const int vok0 = (kr0 * QKD + kc0 * 8) * 2, vok1 = (kr1 * QKD + kc1 * 8) * 2, vok2 = (kr2 * QKD + kc2 * 8) * 2;
  const int vov0 = (vd0 * NKEY + vc0 * 8) * 2, vov1 = ((vd0 + 32) * NKEY + vc0 * 8) * 2;
  {
    pk0 = BLD128(rsk, vok0, 0); pk1_ = BLD128(rsk, vok1, 0); pk2_ = BLD128(rsk, vok2, 0);
    pv0 = BLD128(rsv, vov0, 0); pv1 = BLD128(rsv, vov1, 0);
    *(u32x4*)(lds + kr0 * 208 + kc0 * 16) = pk0; *(u32x4*)(lds + kr1 * 208 + kc1 * 16) = pk1_; *(u32x4*)(lds + kr2 * 208 + kc2 * 16) = pk2_;
    *(u32x4*)(lds + 13312 + vd0 * 144 + vc0 * 16) = pv0; *(u32x4*)(lds + 13312 + (vd0 + 32) * 144 + vc0 * 16) = pv1;
  }
  __syncthreads();
  const int krow = swap23(r);
  const int kfo = krow * 208 + 16 * hh;
  const int vfo = 13312 + r * 144 + 16 * hh;
  constexpr int NTILE = NKEY / 64;
  for (int t = 0; t < NTILE; ++t) {
    const int cur = (t & 1) * KSTG;
    const bool more = (t + 1 < NTILE);
    if (more) {
      const int sk = (t + 1) * (64 * QKD * 2), sv = (t + 1) * 128;
      pk0 = BLD128(rsk, vok0, sk); pk1_ = BLD128(rsk, vok1, sk); pk2_ = BLD128(rsk, vok2, sk);
      pv0 = BLD128(rsv, vov0, sv); pv1 = BLD128(rsv, vov1, sv);
    }
    attn_sub2(lds + cur, kfo, vfo, 0, qfa, qfb, O0a, O1a, O0b, O1b, mruna, lruna, mrunb, lrunb, t == 0);
    __builtin_amdgcn_sched_barrier(0);
    attn_sub2(lds + cur, kfo, vfo, 1, qfa, qfb, O0a, O1a, O0b, O1b, mruna, lruna, mrunb, lrunb, false);
    if (more) {
      const int nxt = (cur == 0) ? KSTG : 0;
      *(u32x4*)(lds + nxt + kr0 * 208 + kc0 * 16) = pk0; *(u32x4*)(lds + nxt + kr1 * 208 + kc1 * 16) = pk1_; *(u32x4*)(lds + nxt + kr2 * 208 + kc2 * 16) = pk2_;
      *(u32x4*)(lds + nxt + 13312 + vd0 * 144 + vc0 * 16) = pv0; *(u32x4*)(lds + nxt + 13312 + (vd0 + 32) * 144 + vc0 * 16) = pv1;
    }
    __syncthreads();
  }
  attn_store(Qit + (size_t)(wid * 64 + r) * 64, hh, O0a, O1a, lruna);
  attn_store(Qit + (size_t)(wid * 64 + 32 + r) * 64, hh, O0b, O1b, lrunb);
}

DI void carry_item(const P& p, int it, int tid) {
  const int b = it / 10, dir = (it / 5) & 1, ch = (it % 5) * 256 + tid;
  const float* sp = (const float*)(p.ws + OFF_SUM) + ((size_t)dir * 136 * LW + ch) * 2;
  float* cp = (float*)(p.ws + OFF_CAR) + (size_t)dir * 128 * LW + ch;
  float cs[34], hs[34];
#pragma unroll
  for (int i = 0; i < 34; ++i) {
    int tile;
    if (dir == 0) tile = i < 2 ? 128 + 2 * b + i : b * 32 + (i - 2);
    else tile = i < 2 ? 129 + 2 * b - i : b * 32 + 31 - (i - 2);
    cs[i] = sp[(size_t)tile * LW * 2]; hs[i] = sp[(size_t)tile * LW * 2 + 1];
  }
  float cy = 0.f;
#pragma unroll
  for (int i = 0; i < 34; ++i) {
    if (i >= 2) { const int j = dir == 0 ? (i - 2) : 31 - (i - 2); cp[(size_t)(b * 32 + j) * LW] = cy; }
    cy = hs[i] + cs[i] * cy;
  }
}
DI void phase4(const P& p, char* lds, int tid0) {
  constexpr int NC = 40, NA = 512, NG = 128 * 40;
  unsigned* flag = (unsigned*)(p.ws + OFF_BAR) + CAR_FLAG_WORD;
  { int tid = tid0; asm volatile("" : "+v"(tid));
    for (int it = blockIdx.x; it < NC; it += gridDim.x) {
      carry_item(p, it, tid);
      asm volatile("s_waitcnt vmcnt(0)" ::: "memory");
      __syncthreads();
      if (tid == 0) { __builtin_amdgcn_fence(__ATOMIC_RELEASE, "agent"); asm volatile("s_waitcnt vmcnt(0)" ::: "memory"); (void)xb_add(flag, 1u); }
    } }
  { int tid = tid0; asm volatile("" : "+v"(tid));
    for (int ia = blockIdx.x; ia < NA; ia += gridDim.x) {
      int pair, qb;
      if (gridDim.x == 512) { const int xcd = ia & 7, slot = ia >> 3; pair = xcd * 4 + (slot >> 4); qb = slot & 15; }
      else { pair = ia >> 4; qb = ia & 15; }
      attn_item(p, pair >> 3, pair & 7, qb, lds, tid);
    } }
  { int tid = tid0; asm volatile("" : "+v"(tid));
    if (tid == 0) {
      unsigned sp_ = 0; while (xb_ld(flag) < (unsigned)NC) { __builtin_amdgcn_s_sleep(2); if (++sp_ > (1u << 22)) break; }
      __builtin_amdgcn_fence(__ATOMIC_ACQUIRE, "agent"); asm volatile("s_waitcnt vmcnt(0)" ::: "memory");
    }
    __syncthreads();
    for (int it = blockIdx.x; it < NG; it += gridDim.x) { int m, n; tile_mn(it, 128, 40, m, n); gates_tile<2>(p, m, n, lds, tid); }
  }
}

struct LoadAT {
  const bf16_t* Q; int m0;
  DI const void* base() const { return Q; }
  DI int voff(int row, int k) const {
    const int t = m0 + row;
    return ((((t >> 12) * NH) * S + (t & 4095 & ~255)) * QKD + (t & 255) * 64 + k) * 2;
  }
  DI int kstep() const { return S * QKD * 2; }
};
#ifndef P5PIPE
#define P5PIPE false
#endif
DI void phase5(const P& p, char* lds, int tid) {
  const int lane = tid & 63, wid = tid >> 6, wr = wid >> 1, wc = wid & 1, fr = lane & 15, fq = lane >> 4;
  const bf16_t* H1 = (const bf16_t*)(p.ws + OFF_H1);
  const bf16_t* WG = (const bf16_t*)(p.ws + OFF_WG);
  bf16_t* M1 = (bf16_t*)(p.ws + OFF_M1);
#pragma unroll 1
  for (int job = 0; job < 2; ++job) {
#pragma unroll 1
    for (int t = blockIdx.x; t < 128 * 8; t += gridDim.x) {
      int m, n; tile_mn(t, 128, 8, m, n);
      bf16_t* GT = (bf16_t*)(p.ws + OFF_Z) + ZC_XB;
      {
        f32x4 acc[4][4]; zero_acc(acc);
        LoadPlain lh{H1 + (size_t)m * 128 * 1024, 1024};
        gemm_k<true>(acc, lh, WG + (size_t)(job * 1024 + n * 128) * 1024, 1024, 1024, lds, tid);
#pragma unroll
        for (int nn = 0; nn < 4; ++nn) {
          const int col = n * 128 + wc * 64 + nn * 16 + fq * 4;
          const f32x4 bg = *(const f32x4*)(p.b_gate + job * 1024 + col);
#pragma unroll
          for (int mm = 0; mm < 4; ++mm) {
            const int row = m * 128 + wr * 64 + mm * 16 + fr;
            *(u32x2*)(GT + (size_t)row * ZLD + col) = (u32x2){pk2(sigm(acc[mm][nn][0] + bg[0]), sigm(acc[mm][nn][1] + bg[1])), pk2(sigm(acc[mm][nn][2] + bg[2]), sigm(acc[mm][nn][3] + bg[3]))};
          }
        }
      }
      f32x4 keep[4][4]; zero_acc(keep);
      if (job == 0) { LoadAT la{(const bf16_t*)(p.ws + OFF_Q), m * 128}; gemm_k<P5PIPE>(keep, la, (const bf16_t*)(p.ws + OFF_WOA) + (size_t)n * 128 * 512, 512, 512, lds, tid); }
      else { LoadPlain la{(const bf16_t*)(p.ws + OFF_Z) + (size_t)m * 128 * ZLD + ZC_YB, ZLD}; gemm_k<P5PIPE>(keep, la, (const bf16_t*)(p.ws + OFF_WOL) + (size_t)n * 128 * LW, LW, LW, lds, tid); }
#pragma unroll
      for (int nn = 0; nn < 4; ++nn) {
        const int col = n * 128 + wc * 64 + nn * 16 + fq * 4;
#pragma unroll
        for (int mm = 0; mm < 4; ++mm) {
          const int row = m * 128 + wr * 64 + mm * 16 + fr;
          const u32x2 g = *(const u32x2*)(GT + (size_t)row * ZLD + col);
          f32x4 v;
          v[0] = bflo(g[0]) * keep[mm][nn][0]; v[1] = bfhi(g[0]) * keep[mm][nn][1];
          v[2] = bflo(g[1]) * keep[mm][nn][2]; v[3] = bfhi(g[1]) * keep[mm][nn][3];
          bf16_t* mp = M1 + (size_t)row * 1024 + col;
          if (job == 1) { const u32x2 pr = *(const u32x2*)mp; v[0] += bflo(pr[0]); v[1] += bfhi(pr[0]); v[2] += bflo(pr[1]); v[3] += bfhi(pr[1]); }
          *(u32x2*)mp = (u32x2){pk2(v[0], v[1]), pk2(v[2], v[3])};
        }
      }
    }
  }
}

DI void resid_epilogue(const P& p, f32x4 (&acc)[4][4], const float* __restrict__ base, int modoff, int m, int n, int tid) {
  const int lane = tid & 63, wid = tid >> 6, wr = wid >> 1, wc = wid & 1, fr = lane & 15, fq = lane >> 4;
  const float* MOD = (const float*)(p.ws + OFF_MOD);
  float* SSQ = (float*)(p.ws + OFF_SSQ2);
#pragma unroll
  for (int mm = 0; mm < 4; ++mm) {
    const int row = m * 128 + wr * 64 + mm * 16 + fr, b = row >> 12;
    float ss = 0.f;
#pragma unroll
    for (int nn = 0; nn < 4; ++nn) {
      const int col = n * 128 + wc * 64 + nn * 16 + fq * 4;
      const f32x4 g = *(const f32x4*)(MOD + (size_t)b * 6144 + modoff + col);
      const f32x4 xv = *(const f32x4*)(base + (size_t)row * 1024 + col);
      const f32x4 v = xv + g * acc[mm][nn];
      *(f32x4*)(p.out + (size_t)row * 1024 + col) = v;
      ss += v[0] * v[0] + v[1] * v[1] + v[2] * v[2] + v[3] * v[3];
    }
    ss += __shfl_xor(ss, 16); ss += __shfl_xor(ss, 32);
    if (fq == 0) SSQ[(size_t)row * 16 + n * 2 + wc] = ss;
  }
}
DI void phase6(const P& p, char* lds, int tid) {
  for (int t = blockIdx.x; t < 128 * 8; t += gridDim.x) {
    int m, n; tile_mn(t, 128, 8, m, n);
    f32x4 acc[4][4]; zero_acc(acc);
    LoadPlain la{(const bf16_t*)(p.ws + OFF_M1) + (size_t)m * 128 * 1024, 1024};
    gemm_k<true>(acc, la, (const bf16_t*)(p.ws + OFF_WOUT) + (size_t)n * 128 * 1024, 1024, 1024, lds, tid);
    resid_epilogue(p, acc, p.x, 2048, m, n, tid);
  }
}
DI void phase8(const P& p, char* lds, int tid) {
  for (int t = blockIdx.x; t < 128 * 8; t += gridDim.x) {
    int m, n; tile_mn(t, 128, 8, m, n);
    f32x4 acc[4][4]; zero_acc(acc);
    LoadPlain la{(const bf16_t*)(p.ws + OFF_FF) + (size_t)m * 128 * FFN, FFN};
    gemm_k<true>(acc, la, (const bf16_t*)(p.ws + OFF_WD) + (size_t)n * 128 * FFN, FFN, FFN, lds, tid);
    resid_epilogue(p, acc, p.out, 5120, m, n, tid);
  }
}

DI void phase7(const P& p, char* lds, int tid) {
  const int lane = tid & 63, wid = tid >> 6, wr = wid >> 1, wc = wid & 1, fr = lane & 15, fq = lane >> 4;
  bf16_t* FF = (bf16_t*)(p.ws + OFF_FF);
  constexpr int MT = 131, NT = 44;
  for (int t = blockIdx.x; t < tile_rect_count(MT, NT); t += gridDim.x) {
    int m, n; if (!tile_rect(t, MT, NT, m, n)) continue;
    const int m0 = m * 126 - 1;
    f32x4 acc[4][4]; zero_acc(acc);
    LoadClamp la{(const bf16_t*)(p.ws + OFF_H1), 1024, m0};
    gemm_k<true>(acc, la, (const bf16_t*)(p.ws + OFF_WUP) + (size_t)n * 128 * 1024, 1024, 1024, lds, tid);
    float* AL = (float*)lds;
#pragma unroll
    for (int mm = 0; mm < 4; ++mm)
#pragma unroll
      for (int nn = 0; nn < 2; ++nn) *(f32x4*)(AL + (wr * 64 + mm * 16 + fr) * 64 + wc * 32 + nn * 16 + fq * 4) = acc[mm][nn];
    __syncthreads();
#pragma unroll
    for (int nn = 0; nn < 2; ++nn) {
      const int chl = wc * 32 + nn * 16 + fq * 4, ch = n * 64 + chl;
      const f32x4 w0 = *(const f32x4*)(p.ffn_conv_w + ch), w1 = *(const f32x4*)(p.ffn_conv_w + FFN + ch), w2 = *(const f32x4*)(p.ffn_conv_w + 2 * FFN + ch);
      const f32x4 cbv = *(const f32x4*)(p.ffn_conv_b + ch);
#pragma unroll
      for (int mm = 0; mm < 4; ++mm) {
        const int rl = wr * 64 + mm * 16 + fr, g = m0 + rl;
        if (rl >= 1 && rl <= 126 && g < TL) {
          const int s = g & 4095;
          f32x4 cv = cbv + w1 * acc[mm][nn];
          if (s > 0) cv += w0 * *(const f32x4*)(AL + (rl - 1) * 64 + chl);
          if (s < S - 1) cv += w2 * *(const f32x4*)(AL + (rl + 1) * 64 + chl);
          f32x4 o;
#pragma unroll
          for (int j = 0; j < 4; ++j) o[j] = cv[j] * sigm(cv[j]) * acc[mm][nn + 2][j];
          *(u32x2*)(FF + (size_t)g * FFN + ch) = (u32x2){pk2(o[0], o[1]), pk2(o[2], o[3])};
        }
      }
    }
    __syncthreads();
  }
}

DI void phase65(const P& p, int tid) {
  const int lane = tid & 63, wid = tid >> 6;
  const float* SSQ = (const float*)(p.ws + OFF_SSQ2);
  const float* GS2 = (const float*)(p.ws + OFF_GS2);
  const float* MOD = (const float*)(p.ws + OFF_MOD);
  bf16_t* H2 = (bf16_t*)(p.ws + OFF_H1);
  for (int it = blockIdx.x; it < TL / 16; it += gridDim.x) {
#pragma unroll
    for (int tt = 0; tt < 4; ++tt) {
      const int row = it * 16 + wid * 4 + tt, b = row >> 12;
      float s = (lane < 16) ? SSQ[(size_t)row * 16 + lane] : 0.f;
      s = wave_sum(s);
      const float rs = rsqrtf(s * (1.f / 1024.f) + EPS);
      const float* xp = p.out + (size_t)row * 1024;
#pragma unroll
      for (int i = 0; i < 4; ++i) {
        const int k = i * 256 + lane * 4;
        const f32x4 v = *(const f32x4*)(xp + k), g = *(const f32x4*)(GS2 + b * 1024 + k), sh = *(const f32x4*)(MOD + (size_t)b * 6144 + 3072 + k);
        const f32x4 y = v * rs * g + sh;
        *(u32x2*)(H2 + (size_t)row * 1024 + k) = (u32x2){pk2(y[0], y[1]), pk2(y[2], y[3])};
      }
    }
  }
}

DI void phase9(const P& p, int tid) {
  const int lane = tid & 63, wid = tid >> 6;
  const float* SSQ = (const float*)(p.ws + OFF_SSQ2);
  for (int it = blockIdx.x; it < TL / 16; it += gridDim.x) {
    for (int tt = 0; tt < 4; ++tt) {
      const int row = it * 16 + wid * 4 + tt;
      float s = (lane < 16) ? SSQ[(size_t)row * 16 + lane] : 0.f;
      s = wave_sum(s);
      const float rs = rsqrtf(s * (1.f / 1024.f) + EPS);
      float* op = p.out + (size_t)row * 1024;
#pragma unroll
      for (int i = 0; i < 4; ++i) {
        const int k = i * 256 + lane * 4;
        const f32x4 v = *(const f32x4*)(op + k), g = *(const f32x4*)(p.final_g + k);
        *(f32x4*)(op + k) = v * rs * g;
      }
    }
  }
}


#ifndef PH_MASK
#define PH_MASK 0x3ff
#endif
#ifndef REP_MASK
#define REP_MASK 0
#endif
__global__ void __launch_bounds__(256, 2) fwd_megakernel(P p) {
  __shared__ __attribute__((aligned(16))) char lds[LDS_BYTES];
  cg::grid_group grid = cg::this_grid();
  if (p.ws == nullptr) grid.sync();
  volatile LAS unsigned* st = (volatile LAS unsigned*)(LAS char*)(lds + LDS_X + 4080);
  if (threadIdx.x == 0) { st[0] = 0u; st[1] = 0u; }
  __syncthreads();
  const XcdBarrier xb = xcd_barrier_post((unsigned*)(p.ws + OFF_BAR), st);
#define PHASE_TID int tid = threadIdx.x; asm volatile("" : "+v"(tid));
#define GRID_SYNC xcd_barrier(xb)
  if (PH_MASK & (1 << 0)) { PHASE_TID phase0(p, lds, tid); }
  if (REP_MASK & (1 << 0)) { GRID_SYNC; PHASE_TID phase0(p, lds, tid); }
  GRID_SYNC;
  if (PH_MASK & (1 << 1)) { PHASE_TID phase1(p, lds, tid); }
  if (REP_MASK & (1 << 1)) { GRID_SYNC; PHASE_TID phase1(p, lds, tid); }
  GRID_SYNC;
  if (PH_MASK & (1 << 2)) { PHASE_TID phase2(p, lds, tid); }
  if (REP_MASK & (1 << 2)) { GRID_SYNC; PHASE_TID phase2(p, lds, tid); }
  GRID_SYNC;
  { PHASE_TID phase25(p, lds, tid); }
  GRID_SYNC;
  if (PH_MASK & (1 << 3)) { PHASE_TID phase3(p, lds, tid); }
  if (REP_MASK & (1 << 3)) { GRID_SYNC; PHASE_TID phase3(p, lds, tid); }
  GRID_SYNC;
  if (PH_MASK & (1 << 4)) { PHASE_TID phase4(p, lds, tid); }
  GRID_SYNC;
  if (PH_MASK & (1 << 5)) { PHASE_TID phase5(p, lds, tid); }
  if (REP_MASK & (1 << 5)) { GRID_SYNC; PHASE_TID phase5(p, lds, tid); }
  GRID_SYNC;
  if (PH_MASK & (1 << 6)) { PHASE_TID phase6(p, lds, tid); }
  if (REP_MASK & (1 << 6)) { GRID_SYNC; PHASE_TID phase6(p, lds, tid); }
  GRID_SYNC;
  { PHASE_TID phase65(p, tid); }
  GRID_SYNC;
  if (PH_MASK & (1 << 7)) { PHASE_TID phase7(p, lds, tid); }
  if (REP_MASK & (1 << 7)) { GRID_SYNC; PHASE_TID phase7(p, lds, tid); }
  GRID_SYNC;
  if (PH_MASK & (1 << 8)) { PHASE_TID phase8(p, lds, tid); }
  GRID_SYNC;
  if (PH_MASK & (1 << 9)) { PHASE_TID phase9(p, tid); }
}

extern "C" void kernel_launch(void* const* d_in, const int* in_sizes, int n_in, void* d_out, int out_size, void* d_ws, size_t ws_size,
                              hipStream_t stream) {
  static int grid_blocks = 0;
  if (!grid_blocks) {
    int dev = 0, cus = 0, per_cu = 0;
    (void)hipGetDevice(&dev);
    (void)hipDeviceGetAttribute(&cus, hipDeviceAttributeMultiprocessorCount, dev);
    (void)hipOccupancyMaxActiveBlocksPerMultiprocessor(&per_cu, fwd_megakernel, 256, 0);
    if (per_cu > 2) per_cu = 2;
    if (per_cu < 1) per_cu = 1;
    grid_blocks = cus * per_cu;
  }
  if (ws_size < WS_END + BAR_BYTES + HALO_BYTES + CAR_BYTES) fprintf(stderr, "workspace too small: %zu < %zu\n", ws_size, (size_t)WS_END);
  P p{};
  const float** f = (const float**)&p;
  for (int i = 0; i < 29; ++i) f[i] = (const float*)d_in[i];
  p.out = (float*)d_out;
  p.ws = (char*)d_ws;
  (void)hipMemsetAsync((char*)d_ws + OFF_BAR, 0, BAR_BYTES, stream);
  void* args[] = {&p};
  hipError_t e = hipLaunchCooperativeKernel((void*)fwd_megakernel, dim3(grid_blocks), dim3(256), args, 0, stream);
  if (e != hipSuccess) fprintf(stderr, "cooperative launch failed: %s (grid %d)\n", hipGetErrorString(e), grid_blocks);
}
```
